# Optimizing an MI355X kernel written in HIP

```python
import functools
import jax, jax.numpy as jnp
from jax import lax
import numpy as np

D_MODEL = 1024
BATCH = 16
SEQ = 2048
DEPTH = 1
DEC_BATCH = 128
DEC_SEQ = 8
PAST_LEN = 8192
PAGE_SIZE = 128

N_META = 16
MLA_HEADS = 8
Q_LORA = 384
KV_LORA = 256
QK_NOPE = 64
QK_ROPE = 32
V_HEAD = 64
ROPE_THETA = 10000.0
CONV_DIM = D_MODEL // 2
CONV_K = 3
D_FF = 4 * D_MODEL
Q_BLOCK = 128
LN_EPS = 1e-5
RMS_EPS = 1e-6
ALPHA = (2.0 * DEPTH) ** 0.25
BETA = (8.0 * DEPTH) ** -0.25
SM_SCALE = (QK_NOPE + QK_ROPE) ** -0.5
SPLIT_SIZES = (Q_LORA, KV_LORA, QK_ROPE, CONV_DIM, CONV_DIM, CONV_DIM, D_MODEL, D_MODEL)
D_IN = Q_LORA + KV_LORA + QK_ROPE + 3 * CONV_DIM + 2 * D_MODEL

kernel_name = "hybrid_conv_mla_deepnorm_step"


def layer_norm(x, g, b):
    xf = x.astype(jnp.float32)
    mu = jnp.mean(xf, axis=-1, keepdims=True)
    var = jnp.mean(jnp.square(xf - mu), axis=-1, keepdims=True)
    y = (xf - mu) * lax.rsqrt(var + LN_EPS) * g.astype(jnp.float32) + b.astype(jnp.float32)
    return y.astype(x.dtype)


def rms_norm(x, g):
    xf = x.astype(jnp.float32)
    y = xf * lax.rsqrt(jnp.mean(jnp.square(xf), axis=-1, keepdims=True) + RMS_EPS) * g.astype(jnp.float32)
    return y.astype(x.dtype)


def rope(x, pos):
    half = QK_ROPE // 2
    inv_freq = ROPE_THETA ** (-2.0 * jnp.arange(half, dtype=jnp.float32) / QK_ROPE)
    ang = pos.astype(jnp.float32)[:, None] * inv_freq[None, :]
    cos = jnp.cos(ang)[:, None, :]
    sin = jnp.sin(ang)[:, None, :]
    xf = x.astype(jnp.float32)
    x1, x2 = xf[..., :half], xf[..., half:]
    return jnp.concatenate([x1 * cos - x2 * sin, x2 * cos + x1 * sin], axis=-1).astype(x.dtype)


def mixer_projections(h, pos, w):
    b, s, _ = h.shape
    offsets = [int(v) for v in np.cumsum(SPLIT_SIZES)[:-1]]
    z = h @ w["w_in"]
    cq, ckv_raw, kpe_raw, gate_b, gate_c, conv_h, gate_cv, gate_ml = jnp.split(z, offsets, axis=-1)
    cq = rms_norm(cq, w["q_norm_g"])
    q = (cq @ w["w_uq"]).reshape(b, s, MLA_HEADS, QK_NOPE + QK_ROPE)
    q_nope, q_pe = q[..., :QK_NOPE], q[..., QK_NOPE:]
    q_pe = rope(q_pe, pos)
    q_lat = jnp.einsum("bshn,chn->bshc", q_nope, w["w_uk"])
    ckv = rms_norm(ckv_raw, w["kv_norm_g"])
    kpe = rope(kpe_raw[:, :, None, :], pos)[:, :, 0, :]
    u = gate_c * conv_h
    g_conv = jax.nn.sigmoid(gate_cv)
    g_mla = jax.nn.sigmoid(gate_ml)
    return q_lat, q_pe, ckv, kpe, gate_b, u, g_conv, g_mla


def short_conv(u, prev, conv_w):
    s = u.shape[1]
    full = jnp.concatenate([prev, u], axis=1)
    out = sum(conv_w[k] * full[:, k:k + s] for k in range(CONV_K))
    return out, full[:, -(CONV_K - 1):]


def attend_prompt(q_lat, q_pe, ckv, kpe):
    b, L = q_lat.shape[0], q_lat.shape[1]
    lp = -(-L // Q_BLOCK) * Q_BLOCK
    pad = lp - L
    nb = lp // Q_BLOCK
    q_lat_p = jnp.pad(q_lat, ((0, 0), (0, pad), (0, 0), (0, 0)))
    q_pe_p = jnp.pad(q_pe, ((0, 0), (0, pad), (0, 0), (0, 0)))
    ckv_p = jnp.pad(ckv, ((0, 0), (0, pad), (0, 0)))
    kpe_p = jnp.pad(kpe, ((0, 0), (0, pad), (0, 0)))
    k_pos = jnp.arange(lp)
    qb = q_lat_p.reshape(b, nb, Q_BLOCK, MLA_HEADS, KV_LORA).swapaxes(0, 1)
    pb = q_pe_p.reshape(b, nb, Q_BLOCK, MLA_HEADS, QK_ROPE).swapaxes(0, 1)
    starts = jnp.arange(nb) * Q_BLOCK

    def block(args):
        ql, qp, start = args
        q_pos = start + jnp.arange(Q_BLOCK)
        sc = (jnp.einsum("bqhc,bkc->bhqk", ql, ckv_p) + jnp.einsum("bqhr,bkr->bhqk", qp, kpe_p)).astype(jnp.float32) * SM_SCALE
        sc = jnp.where(k_pos[None, :] <= q_pos[:, None], sc, -jnp.inf)
        p = jax.nn.softmax(sc, axis=-1).astype(ckv_p.dtype)
        return jnp.einsum("bhqk,bkc->bqhc", p, ckv_p)

    o = lax.map(block, (qb, pb, starts))
    return o.swapaxes(0, 1).reshape(b, lp, MLA_HEADS, KV_LORA)[:, :L]


def attend_sample(q_lat, q_pe, ckv_new, kpe_new, ckv_pool, kpe_pool, page_table):
    db = page_table.shape[0]
    n = q_lat.shape[1]
    past_ckv = ckv_pool[page_table].reshape(db, -1, KV_LORA)
    past_kpe = kpe_pool[page_table].reshape(db, -1, QK_ROPE)
    past = past_ckv.shape[1]
    s_past = jnp.einsum("bqhc,bkc->bhqk", q_lat, past_ckv) + jnp.einsum("bqhr,bkr->bhqk", q_pe, past_kpe)
    s_new = jnp.einsum("bqhc,bkc->bhqk", q_lat, ckv_new) + jnp.einsum("bqhr,bkr->bhqk", q_pe, kpe_new)
    s_new = jnp.where(jnp.tril(jnp.ones((n, n), dtype=bool)), s_new.astype(jnp.float32), -jnp.inf)
    sc = jnp.concatenate([s_past.astype(jnp.float32), s_new], axis=-1) * SM_SCALE
    p = jax.nn.softmax(sc, axis=-1).astype(ckv_new.dtype)
    return (jnp.einsum("bhqk,bkc->bqhc", p[..., :past], past_ckv)
            + jnp.einsum("bhqk,bkc->bqhc", p[..., past:], ckv_new))


def layer_forward(h, pos, conv_prev, attend, w):
    b, s, _ = h.shape
    q_lat, q_pe, ckv, kpe, gate_b, u, g_conv, g_mla = mixer_projections(h, pos, w)
    conv_out, conv_state = short_conv(u, conv_prev, w["conv_w"])
    y_conv = (gate_b * conv_out) @ w["w_conv_out"]
    o_lat = attend(q_lat, q_pe, ckv, kpe)
    v = jnp.einsum("bshc,chv->bshv", o_lat, w["w_uv"]).reshape(b, s, MLA_HEADS * V_HEAD)
    y_mla = v @ w["w_o_mla"]
    mix = (g_conv * y_conv + g_mla * y_mla) @ w["w_o"]
    h1 = layer_norm(ALPHA * h + mix, w["ln1_g"], w["ln1_b"])
    ff = jnp.square(jax.nn.relu(h1 @ w["w_up"])) @ w["w_down"]
    h2 = layer_norm(ALPHA * h1 + ff, w["ln2_g"], w["ln2_b"])
    return h2, ckv, kpe, conv_state


def setup_inputs(seed: int = 0) -> dict:
    key = jax.random.key(seed)
    ks = jax.random.split(key, 32)
    f32 = jnp.float32
    nrm = lambda k, shape, scale: jax.random.normal(k, shape, f32) * scale
    n_pages = PAST_LEN // PAGE_SIZE
    n_used = DEC_BATCH * n_pages
    n_pool = n_used + n_used // 4
    page_table = jax.random.permutation(ks[5], n_pool)[:n_used].reshape(DEC_BATCH, n_pages).astype(jnp.int32)
    return {
        "x_prompt": nrm(ks[0], (BATCH, SEQ, D_MODEL), 1.0),
        "x_sample": nrm(ks[1], (DEC_BATCH, DEC_SEQ, D_MODEL), 1.0),
        "cache_ckv": nrm(ks[2], (DEPTH, n_pool, PAGE_SIZE, KV_LORA), 1.0),
        "cache_kpe": nrm(ks[3], (DEPTH, n_pool, PAGE_SIZE, QK_ROPE), 1.0),
        "state_conv": nrm(ks[4], (DEPTH, DEC_BATCH, CONV_K - 1, CONV_DIM), 1.0),
        "page_table": page_table,
        "meta_tokens": nrm(ks[6], (N_META, D_MODEL), 1.0),
        "ln_emb_g": 1.0 + nrm(ks[7], (D_MODEL,), 0.02),
        "ln_emb_b": nrm(ks[8], (D_MODEL,), 0.02),
        "w_in": nrm(ks[9], (DEPTH, D_MODEL, D_IN), D_MODEL ** -0.5),
        "q_norm_g": 1.0 + nrm(ks[10], (DEPTH, Q_LORA), 0.02),
        "w_uq": nrm(ks[11], (DEPTH, Q_LORA, MLA_HEADS * (QK_NOPE + QK_ROPE)), Q_LORA ** -0.5),
        "kv_norm_g": 1.0 + nrm(ks[12], (DEPTH, KV_LORA), 0.02),
        "w_uk": nrm(ks[13], (DEPTH, KV_LORA, MLA_HEADS, QK_NOPE), KV_LORA ** -0.5),
        "w_uv": nrm(ks[14], (DEPTH, KV_LORA, MLA_HEADS, V_HEAD), KV_LORA ** -0.5),
        "w_o_mla": nrm(ks[15], (DEPTH, MLA_HEADS * V_HEAD, D_MODEL), (MLA_HEADS * V_HEAD) ** -0.5),
        "conv_w": nrm(ks[16], (DEPTH, CONV_K, CONV_DIM), CONV_K ** -0.5),
        "w_conv_out": nrm(ks[17], (DEPTH, CONV_DIM, D_MODEL), CONV_DIM ** -0.5),
        "w_o": nrm(ks[18], (DEPTH, D_MODEL, D_MODEL), BETA * D_MODEL ** -0.5),
        "ln1_g": 1.0 + nrm(ks[19], (DEPTH, D_MODEL), 0.02),
        "ln1_b": nrm(ks[20], (DEPTH, D_MODEL), 0.02),
        "w_up": nrm(ks[21], (DEPTH, D_MODEL, D_FF), D_MODEL ** -0.5),
        "w_down": nrm(ks[22], (DEPTH, D_FF, D_MODEL), BETA * D_FF ** -0.5),
        "ln2_g": 1.0 + nrm(ks[23], (DEPTH, D_MODEL), 0.02),
        "ln2_b": nrm(ks[24], (DEPTH, D_MODEL), 0.02),
    }


def reference(x_prompt, x_sample, cache_ckv, cache_kpe, state_conv, page_table, meta_tokens,
              ln_emb_g, ln_emb_b, w_in, q_norm_g, w_uq, kv_norm_g, w_uk, w_uv, w_o_mla,
              conv_w, w_conv_out, w_o, ln1_g, ln1_b, w_up, w_down, ln2_g, ln2_b):
    bp, sp, _ = x_prompt.shape
    meta = jnp.broadcast_to(meta_tokens[None].astype(x_prompt.dtype), (bp, N_META, D_MODEL))
    hp = layer_norm(jnp.concatenate([meta, x_prompt], axis=1), ln_emb_g, ln_emb_b)
    hs = layer_norm(x_sample, ln_emb_g, ln_emb_b)
    pos_p = jnp.arange(N_META + sp)
    past_len = page_table.shape[1] * PAGE_SIZE
    pos_s = past_len + jnp.arange(x_sample.shape[1])
    conv_zero = jnp.zeros((bp, CONV_K - 1, CONV_DIM), dtype=hp.dtype)
    ckv_p_l, kpe_p_l, conv_p_l, ckv_s_l, kpe_s_l, conv_s_l = [], [], [], [], [], []
    for l in range(DEPTH):
        w = {
            "w_in": w_in[l], "q_norm_g": q_norm_g[l], "w_uq": w_uq[l], "kv_norm_g": kv_norm_g[l],
            "w_uk": w_uk[l], "w_uv": w_uv[l], "w_o_mla": w_o_mla[l], "conv_w": conv_w[l],
            "w_conv_out": w_conv_out[l], "w_o": w_o[l], "ln1_g": ln1_g[l], "ln1_b": ln1_b[l],
            "w_up": w_up[l], "w_down": w_down[l], "ln2_g": ln2_g[l], "ln2_b": ln2_b[l],
        }
        hp, ckv_p, kpe_p, conv_p = layer_forward(hp, pos_p, conv_zero, attend_prompt, w)
        attend_s = functools.partial(attend_sample, ckv_pool=cache_ckv[l], kpe_pool=cache_kpe[l], page_table=page_table)
        hs, ckv_s, kpe_s, conv_s = layer_forward(hs, pos_s, state_conv[l], attend_s, w)
        ckv_p_l.append(ckv_p); kpe_p_l.append(kpe_p); conv_p_l.append(conv_p)
        ckv_s_l.append(ckv_s); kpe_s_l.append(kpe_s); conv_s_l.append(conv_s)
    y_prompt = hp[:, N_META:]
    y_sample = hs
    return (y_prompt, y_sample,
            jnp.stack(ckv_p_l), jnp.stack(kpe_p_l), jnp.stack(conv_p_l),
            jnp.stack(ckv_s_l), jnp.stack(kpe_s_l), jnp.stack(conv_s_l))
```

```cpp
#include <hip/hip_runtime.h>
#include <cstdio>
#include <cstdint>
#include <cmath>
#define MK_N_LAUNCHES 1
constexpr int D = 1024, NB = 16, SEQ = 2048, NMETA = 16, LP = SEQ + NMETA;
constexpr int DBATCH = 128, DSEQ = 8, PAST = 8192, PAGE = 128, NPG = PAST / PAGE;
constexpr int NH = 8, QLORA = 384, KVL = 256, NOPE = 64, ROPE = 32, QHD = NOPE + ROPE, VHD = 64;
constexpr int CDIM = 512, FF = 4096, DIN = 4256;
constexpr int M_P = NB * SEQ;
constexpr int M_S = DBATCH * DSEQ;
constexpr int ROW_S = M_P, ROW_M = M_P + M_S;
constexpr int M_ALL = ROW_M + 256;
constexpr int NZ = 4352;
constexpr int NTAB = LP + DSEQ;
constexpr float LN_EPS = 1e-5f, RMS_EPS = 1e-6f;
constexpr float ALPHA = 1.189207115002721f;
constexpr float QSCALE = 0.10206207261596577f * 1.4426950408889634f;
constexpr int NSPLIT = 8;

constexpr int ZC_CQ = 0, ZC_CKV = 384, ZC_KPE = 640, ZC_GB = 672, ZC_GC = 1184, ZC_CH = 1696, ZC_GCV = 2208, ZC_GML = 3232;

constexpr size_t O_YP = 0, O_YS = O_YP + (size_t)M_P * D, O_CKVP = O_YS + (size_t)M_S * D, O_KPEP = O_CKVP + (size_t)NB * LP * KVL,
                 O_CONVP = O_KPEP + (size_t)NB * LP * ROPE, O_CKVS = O_CONVP + (size_t)NB * 2 * CDIM, O_KPES = O_CKVS + (size_t)M_S * KVL,
                 O_CONVS = O_KPES + (size_t)M_S * ROPE, O_END = O_CONVS + (size_t)DBATCH * 2 * CDIM;

constexpr size_t MiB = 1u << 20;
constexpr size_t al(size_t x) { return (x + MiB - 1) / MiB * MiB; }
constexpr size_t WS_CTL = 0, CTL_ZERO_BYTES = 1 * MiB;
constexpr size_t WS_WIN = 1 * MiB;
constexpr size_t WS_WUQ = WS_WIN + al((size_t)NZ * D * 2);
constexpr size_t WS_WABS = WS_WUQ + al((size_t)768 * QLORA * 2);
constexpr size_t WS_WKV = WS_WABS + al((size_t)2048 * QLORA * 2);
constexpr size_t WS_WCO = WS_WKV + al((size_t)1024 * KVL * 2);
constexpr size_t WS_WOM = WS_WCO + al((size_t)D * CDIM * 2);
constexpr size_t WS_WO = WS_WOM + al((size_t)D * 512 * 2);
constexpr size_t WS_WUP = WS_WO + al((size_t)D * D * 2);
constexpr size_t WS_WDN = WS_WUP + al((size_t)FF * D * 2);
constexpr size_t WS_TAB = WS_WDN + al((size_t)D * FF * 2);
constexpr size_t WS_XN = WS_TAB + al((size_t)NTAB * 32 * 4);
constexpr size_t WS_H32 = WS_XN + al((size_t)M_ALL * D * 2);
constexpr size_t WS_ZF = WS_H32 + al((size_t)M_ALL * D * 4);
constexpr size_t WS_GB = WS_ZF + al((size_t)M_ALL * 768 * 4);
constexpr size_t WS_U = WS_GB + al((size_t)M_ALL * 512 * 2);
constexpr size_t WS_GCV = WS_U + al((size_t)M_ALL * 512 * 2);
constexpr size_t WS_GML = WS_GCV + al((size_t)M_ALL * D * 2);
constexpr size_t WS_CQN = WS_GML + al((size_t)M_ALL * D * 2);
constexpr size_t WS_CKV = WS_CQN + al((size_t)M_ALL * QLORA * 2);
constexpr size_t WS_KPE = WS_CKV + al((size_t)M_ALL * KVL * 2);
constexpr size_t WS_CV = WS_KPE + al((size_t)M_ALL * ROPE * 2);
constexpr size_t WS_Q = WS_CV + al((size_t)M_ALL * CDIM * 2);
constexpr size_t WS_KV = WS_Q + al((size_t)M_ALL * 768 * 2);
constexpr size_t WS_QLAT = WS_KV + al((size_t)M_ALL * 1024 * 2);
constexpr size_t WS_O = WS_QLAT + al((size_t)M_S * 2048 * 2);
constexpr size_t WS_PART = WS_O + al((size_t)M_ALL * 512 * 2);
constexpr size_t WS_T = WS_PART + al((size_t)DBATCH * NSPLIT * 64 * 264 * 4);
constexpr size_t WS_MIXIN = WS_T + al((size_t)M_ALL * D * 4);
constexpr size_t WS_R1 = WS_MIXIN + al((size_t)M_ALL * D * 2);
constexpr size_t WS_H1 = WS_R1 + al((size_t)M_ALL * D * 4);
constexpr size_t WS_H1N = WS_H1 + al((size_t)M_ALL * D * 4);
constexpr size_t WS_UP = WS_H1N + al((size_t)M_ALL * D * 2);
constexpr size_t WS_R2 = WS_UP + al((size_t)M_ALL * FF * 2);
constexpr size_t WS_END = WS_R2 + al((size_t)M_ALL * D * 4);
constexpr int CW_TMO = 0, CW_CODE = 1, CW_BAR = 4096;

constexpr int RING_OFF = 0, RING_BYTES = 131072;
constexpr int LDSCTL_OFF = RING_BYTES, MISC_OFF = LDSCTL_OFF + 320;
constexpr int LDS_BYTES = 147456;
constexpr int NWAVES = 8;
namespace pg8 {
#define PG8_LAS __attribute__((address_space(3)))
typedef unsigned short bf16_t;
typedef short bf16x8 __attribute__((ext_vector_type(8)));
typedef float f32x4 __attribute__((ext_vector_type(4)));
typedef unsigned u32x4 __attribute__((ext_vector_type(4)));
constexpr int BM = 256, BK = 64, HALF = 128, HTB = HALF * BK * 2  , STAGE_BYTES = 8 * HTB, NXCD = 8, WGM = 8;

__host__ __device__ __forceinline__ int lds_byte(int r, int c) { const int st = (r >> 4) * 2 + (c >> 5), rr = r & 15, cc = c & 31, ob = rr * 64 + cc * 2; return st * 1024 + (ob ^ (((ob >> 9) & 1) << 5)); }
__host__ __device__ __forceinline__ void stage_rc(int b, int& R, int& C) { const int st = b / 1024, sb = b % 1024, swz = sb ^ (((sb >> 9) & 1) << 5); R = (st >> 1) * 16 + swz / 64; C = (st & 1) * 32 + (swz % 64) / 2; }
__host__ __device__ __forceinline__ int perm32(int rho) { const int n = rho >> 4, i = rho & 15; return 8 * (i >> 2) + 4 * n + (i & 3); }

struct Unit { int pm, pn; };
struct Gemm { const bf16_t* A; const bf16_t* Bt; int M, N, K; };

struct StaticOrder {
    int nM, nN, nwg, G, c;
    __host__ __device__ void init(int M, int N, int G_, int c_) { nM = M / BM; nN = N / BM; nwg = nM * nN; G = G_; c = c_; }
    __host__ __device__ bool next(int i, Unit& u) const {
        const long L = (long)i * G + c; if (L >= nwg) return false;
        int wgid = (int)L; { const int q = nwg / NXCD, r = nwg % NXCD, xcd = wgid % NXCD, off = wgid / NXCD; wgid = (xcd < r ? xcd * (q + 1) : r * (q + 1) + (xcd - r) * q) + off; }
        const int nig = WGM * nN, gid = wgid / nig, fm = gid * WGM, gsz = (nM - fm) < WGM ? (nM - fm) : WGM;
        u.pm = fm + ((wgid % nig) % gsz); u.pn = (wgid % nig) / gsz; return true;
    }
    __device__ __forceinline__ void a_ready(const Unit&) const {}
    __device__ __forceinline__ void done(const Unit&) const {}
};

__device__ __forceinline__ unsigned cvt_pk_bf16(float lo, float hi) { unsigned r; asm volatile("v_cvt_pk_bf16_f32 %0, %1, %2" : "=v"(r) : "v"(lo), "v"(hi)); return r; }
typedef float f32x2 __attribute__((ext_vector_type(2)));
template <class Epi, class Sched, bool ALIGN_EPI = false, bool SP2 = false>
__device__ __forceinline__ void gemm_phase(PG8_LAS unsigned char* lds, const Gemm g, const Sched& S, const Epi& E) {
    const int tid = threadIdx.x, wid = __builtin_amdgcn_readfirstlane(tid >> 6), lane = tid & 63, wr = wid >> 2, wc = wid & 3, fr = lane & 15, fq = lane >> 4;
    const int K = g.K, nt = K / BK;
    unsigned voffA[2], voffB[2];
#pragma unroll
    for (int i = 0; i < 2; ++i) { int R, C; stage_rc(tid * 16 + i * 8192, R, C); const int Rb = Epi::PERM ? ((R & ~31) + perm32(R & 31)) : R;
        voffA[i] = (unsigned)(R * K + C) * 2u; voffB[i] = (unsigned)(Rb * K + C) * 2u; }
    const size_t kstep = (size_t)(BK * 2);
    const size_t hstep = (size_t)HALF * K * 2;
    const size_t tstep = 2 * hstep;
    const unsigned ldsw = (unsigned)wid * 1024u;
    const int aoff = lds_byte(wr * 64 + fr, fq * 8), boff = lds_byte(wc * 32 + fr, fq * 8);
#define PG8_SA(b, h) (((b) * 2 + (h)) * HTB)
#define PG8_SB(b, h) ((4 + (b) * 2 + (h)) * HTB)
#define PG8_STAGE(bufoff, gbase, voff) do { _Pragma("unroll") for (int _i = 0; _i < 2; ++_i) \
        __builtin_amdgcn_global_load_lds((const unsigned*)((const char*)(gbase) + (voff)[_i]), (PG8_LAS unsigned*)(lds + (bufoff) + ldsw + _i * 8192), 16, 0, 0); } while (0)
#define PG8_LDA(dst, b, h) do { _Pragma("unroll") for (int m = 0; m < 4; ++m) _Pragma("unroll") for (int k = 0; k < 2; ++k) dst[m][k] = *(const PG8_LAS bf16x8*)(lds + PG8_SA(b, h) + aoff + m * 2048 + k * 1024); } while (0)
#define PG8_LDB(dst, b, h) do { _Pragma("unroll") for (int n = 0; n < 2; ++n) _Pragma("unroll") for (int k = 0; k < 2; ++k) dst[n][k] = *(const PG8_LAS bf16x8*)(lds + PG8_SB(b, h) + boff + n * 2048 + k * 1024); } while (0)
#define PG8_MMA(ai, bj, At, Bt) do { __builtin_amdgcn_s_setprio(1); _Pragma("unroll") for (int m = 0; m < 4; ++m) _Pragma("unroll") for (int n = 0; n < 2; ++n) _Pragma("unroll") for (int k = 0; k < 2; ++k) \
        acc[ai][bj][m][n] = __builtin_amdgcn_mfma_f32_16x16x32_bf16(Bt[n][k], At[m][k], acc[ai][bj][m][n], 0, 0, 0); __builtin_amdgcn_s_setprio(0); } while (0)
#define PG8_WAIT_V(n) asm volatile("s_waitcnt vmcnt(" #n ")" ::: "memory")
#define PG8_WAIT_L(n) asm volatile("s_waitcnt lgkmcnt(" #n ")" ::: "memory")
#define PG8_BAR __builtin_amdgcn_s_barrier()
#define PG8_SCHED __builtin_amdgcn_sched_barrier(0)
    Unit cur, nxt; int ui = 0;
    if (!S.next(0, cur)) return;
    f32x4 acc[2][2][4][2];
#pragma unroll
    for (int a = 0; a < 2; ++a)
#pragma unroll
        for (int b = 0; b < 2; ++b)
#pragma unroll
            for (int m = 0; m < 4; ++m)
#pragma unroll
                for (int n = 0; n < 2; ++n) acc[a][b][m][n] = (f32x4){0.f, 0.f, 0.f, 0.f};
    bf16x8 At[4][2], B0[2][2], B1[2][2];
    const char* cA = (const char*)g.A + (size_t)cur.pm * tstep; const char* cB = (const char*)g.Bt + (size_t)cur.pn * tstep;
    S.a_ready(cur);
    if constexpr (SP2) {
        PG8_STAGE(PG8_SB(0, 0), cB, voffB); PG8_STAGE(PG8_SB(0, 1), cB + hstep, voffB); PG8_STAGE(PG8_SA(0, 0), cA, voffA); PG8_STAGE(PG8_SA(0, 1), cA + hstep, voffA);
        if (wr == 1) PG8_BAR;
        PG8_WAIT_V(2); PG8_BAR;
        PG8_STAGE(PG8_SB(1, 0), cB + kstep, voffB); PG8_STAGE(PG8_SA(1, 0), cA + kstep, voffA); PG8_STAGE(PG8_SB(1, 1), cB + hstep + kstep, voffB);
        PG8_WAIT_V(6); PG8_BAR;
    } else {
        PG8_STAGE(PG8_SB(0, 0), cB, voffB); PG8_STAGE(PG8_SA(0, 0), cA, voffA); PG8_STAGE(PG8_SB(0, 1), cB + hstep, voffB); PG8_STAGE(PG8_SA(0, 1), cA + hstep, voffA);
        if (wr == 1) PG8_BAR;
        PG8_WAIT_V(4); PG8_BAR;
        PG8_STAGE(PG8_SB(1, 0), cB + kstep, voffB); PG8_STAGE(PG8_SA(1, 0), cA + kstep, voffA); PG8_STAGE(PG8_SB(1, 1), cB + hstep + kstep, voffB);
        PG8_WAIT_V(6); PG8_BAR;
    }
    for (;;) {
        const bool has_next = S.next(ui + 1, nxt);
        const char* nA = has_next ? (const char*)g.A + (size_t)nxt.pm * tstep : cA; const char* nB = has_next ? (const char*)g.Bt + (size_t)nxt.pn * tstep : cB;
#pragma unroll 1
        for (int t = 0; t < nt; t += 2) {
            const bool last = (t == nt - 2);
            const char* a1 = cA + (size_t)(t + 1) * kstep;
            const char* a2 = last ? nA : cA + (size_t)(t + 2) * kstep; const char* b2 = last ? nB : cB + (size_t)(t + 2) * kstep;
            const char* a3 = a2 + kstep; const char* b3 = b2 + kstep;
            if (last && has_next) S.a_ready(nxt);
            if constexpr (SP2) {
            PG8_LDB(B0, 0, 0); PG8_LDB(B1, 0, 1); PG8_SCHED; PG8_LDA(At, 0, 0); PG8_STAGE(PG8_SA(1, 1), a1 + hstep, voffA);
            PG8_WAIT_V(8); PG8_WAIT_L(0); PG8_BAR; PG8_MMA(0, 0, At, B0); PG8_MMA(0, 1, At, B1); PG8_BAR; PG8_SCHED;
            PG8_LDA(At, 0, 1); PG8_STAGE(PG8_SB(0, 0), b2, voffB); PG8_STAGE(PG8_SB(0, 1), b2 + hstep, voffB); PG8_STAGE(PG8_SA(0, 0), a2, voffA);
            PG8_WAIT_V(8); PG8_WAIT_L(0); PG8_BAR; PG8_MMA(1, 0, At, B0); PG8_MMA(1, 1, At, B1); PG8_BAR; PG8_SCHED;
            PG8_LDB(B0, 1, 0); PG8_LDB(B1, 1, 1); PG8_SCHED; PG8_LDA(At, 1, 0); PG8_STAGE(PG8_SA(0, 1), a2 + hstep, voffA);
            PG8_WAIT_V(8); PG8_WAIT_L(0); PG8_BAR; PG8_MMA(0, 0, At, B0); PG8_MMA(0, 1, At, B1); PG8_BAR; PG8_SCHED;
            PG8_LDA(At, 1, 1); PG8_STAGE(PG8_SB(1, 0), b3, voffB); PG8_STAGE(PG8_SB(1, 1), b3 + hstep, voffB); PG8_STAGE(PG8_SA(1, 0), a3, voffA);
            PG8_WAIT_V(8); PG8_WAIT_L(0); PG8_BAR; PG8_MMA(1, 0, At, B0); PG8_MMA(1, 1, At, B1); PG8_BAR; PG8_SCHED;
            } else {
            PG8_LDB(B0, 0, 0); PG8_SCHED; PG8_LDA(At, 0, 0); PG8_STAGE(PG8_SA(1, 1), a1 + hstep, voffA);
            PG8_WAIT_L(8); PG8_BAR; PG8_WAIT_L(0); PG8_MMA(0, 0, At, B0); PG8_BAR; PG8_SCHED;
            PG8_LDB(B1, 0, 1); PG8_STAGE(PG8_SB(0, 0), b2, voffB);
            PG8_BAR; PG8_WAIT_L(0); PG8_MMA(0, 1, At, B1); PG8_BAR;
            PG8_LDA(At, 0, 1); PG8_STAGE(PG8_SA(0, 0), a2, voffA);
            PG8_BAR; PG8_WAIT_L(0); PG8_MMA(1, 0, At, B0); PG8_BAR; PG8_SCHED;
            PG8_STAGE(PG8_SB(0, 1), b2 + hstep, voffB);
            PG8_WAIT_V(6); PG8_BAR; PG8_MMA(1, 1, At, B1); PG8_BAR;
            PG8_LDB(B0, 1, 0); PG8_SCHED; PG8_LDA(At, 1, 0); PG8_STAGE(PG8_SA(0, 1), a2 + hstep, voffA);
            PG8_WAIT_L(8); PG8_BAR; PG8_WAIT_L(0); PG8_MMA(0, 0, At, B0); PG8_BAR; PG8_SCHED;
            PG8_LDB(B1, 1, 1); PG8_STAGE(PG8_SB(1, 0), b3, voffB);
            PG8_BAR; PG8_WAIT_L(0); PG8_MMA(0, 1, At, B1); PG8_BAR;
            PG8_LDA(At, 1, 1); PG8_STAGE(PG8_SA(1, 0), a3, voffA);
            PG8_BAR; PG8_WAIT_L(0); PG8_MMA(1, 0, At, B0); PG8_BAR; PG8_SCHED;
            PG8_STAGE(PG8_SB(1, 1), b3 + hstep, voffB);
            PG8_WAIT_V(6); PG8_BAR; PG8_MMA(1, 1, At, B1); PG8_BAR;
            }
        }
        if constexpr (ALIGN_EPI) { if (wr == 0) PG8_BAR; }
        if constexpr (!Epi::AFTER_DRAIN) { E(acc, cur, wr, wc, fr, fq); S.done(cur); }
        if (!has_next) break;
#pragma unroll
        for (int a = 0; a < 2; ++a)
#pragma unroll
            for (int b = 0; b < 2; ++b)
#pragma unroll
                for (int m = 0; m < 4; ++m)
#pragma unroll
                    for (int n = 0; n < 2; ++n) acc[a][b][m][n] = (f32x4){0.f, 0.f, 0.f, 0.f};
        cur = nxt; cA = nA; cB = nB; ++ui;
        if constexpr (ALIGN_EPI) { if (wr == 1) PG8_BAR; }
    }
    PG8_WAIT_V(0);
    if constexpr (!ALIGN_EPI) { if (wr == 0) PG8_BAR; }
    PG8_BAR;
    if constexpr (Epi::AFTER_DRAIN) { E.fused(acc, cur, wr, wc, fr, fq, lds, wid, lane); S.done(cur); }
#undef PG8_SA
#undef PG8_SB
#undef PG8_STAGE
#undef PG8_LDA
#undef PG8_LDB
#undef PG8_MMA
#undef PG8_WAIT_V
#undef PG8_WAIT_L
#undef PG8_BAR
#undef PG8_SCHED
}
}
#define GAS __attribute__((address_space(1)))
#define LAS __attribute__((address_space(3)))
typedef unsigned short bf16;
typedef unsigned v4u __attribute__((ext_vector_type(4)));
typedef float f32x4 __attribute__((ext_vector_type(4)));
typedef short bf16x8 __attribute__((ext_vector_type(8)));
typedef GAS unsigned gu32;
typedef GAS unsigned long long gu64;
#define RLX_AGENT __ATOMIC_RELAXED, __HIP_MEMORY_SCOPE_AGENT
#define LDS_WAIT() asm volatile("s_waitcnt lgkmcnt(0)" ::: "memory")
#define VM_WAIT() asm volatile("s_waitcnt vmcnt(0)" ::: "memory")
__device__ __forceinline__ unsigned long long rt() { return __builtin_amdgcn_s_memrealtime(); }
__device__ __forceinline__ unsigned f2bf(float f) { unsigned u = __builtin_bit_cast(unsigned, f); return (u + 0x7fffu + ((u >> 16) & 1u)) >> 16; }
__device__ __forceinline__ unsigned pk2(float lo, float hi) { return f2bf(lo) | (f2bf(hi) << 16); }

#define XB_TMO      128
#define XB_XCNT(j)  (256  + 64 * (j))
#define XB_XSUB(j)  (1280 + 64 * (j))
#define XB_XGEN(j)  (2304 + 64 * (j))
#define XB_TOP      3328
#define XB_TOPGEN   3392
#define XCD_BAR_WORDS 3456
#define XB_SPIN_CAP (1u << 18)

__device__ __forceinline__ unsigned xb_ld(unsigned* p)              { return __hip_atomic_load(p, __ATOMIC_RELAXED, __HIP_MEMORY_SCOPE_AGENT); }
__device__ __forceinline__ unsigned xb_add(unsigned* p, unsigned v) { return __hip_atomic_fetch_add(p, v, __ATOMIC_RELAXED, __HIP_MEMORY_SCOPE_AGENT); }
__device__ __forceinline__ unsigned xb_xcc_id() { return (unsigned)__builtin_amdgcn_s_getreg((3 << 11) | 20) & 0xFu; }
#define XB_SPIN(cond, bar) do { unsigned _sp = 0; while (cond) { __builtin_amdgcn_s_sleep(1); \
    if ((++_sp & 255u) == 0u) { if (xb_ld(&(bar)[XB_TMO])) break; if (_sp > XB_SPIN_CAP) { atomicAdd(&(bar)[XB_TMO], 1u); break; } } } } while (0)

struct XcdBarrier {
    unsigned* bar; unsigned x;
    volatile LAS unsigned* st;
};

__device__ __forceinline__ XcdBarrier xcd_barrier_post(unsigned* bar, volatile LAS unsigned* st) {
    XcdBarrier b; b.bar = bar; b.x = xb_xcc_id(); b.st = st;
    if (threadIdx.x == 0) (void)xb_add(&bar[XB_XCNT(b.x)], 1u);
    return b;
}
__device__ __forceinline__ void xcd_barrier_complete(unsigned* bar, unsigned x, unsigned& nloc, unsigned& nx) {
    const unsigned G = gridDim.x * gridDim.y * gridDim.z;
    unsigned sum, cnt, mine, sp = 0u;
    for (;;) {
        sum = 0u; cnt = 0u; mine = 0u;
#pragma unroll
        for (unsigned j = 0; j < 16; ++j) { const unsigned c = xb_ld(&bar[XB_XCNT(j)]); sum += c; cnt += (c > 0u) ? 1u : 0u; mine = (j == x) ? c : mine; }
        if (sum == G) break;
        __builtin_amdgcn_s_sleep(1);
        if ((++sp & 255u) == 0u) { if (xb_ld(&bar[XB_TMO])) break; if (sp > XB_SPIN_CAP) { atomicAdd(&bar[XB_TMO], 1u); break; } }
    }
    nloc = mine > 0u ? mine : 1u; nx = cnt > 0u ? cnt : 1u;
}

__device__ __forceinline__ void xcd_barrier(const XcdBarrier& b) {
    asm volatile("s_waitcnt vmcnt(0)" ::: "memory");
    __syncthreads();
    if (threadIdx.x == 0) {
        unsigned* bar = b.bar;
        __builtin_amdgcn_s_waitcnt(0);
        unsigned nloc = b.st[0], nx = b.st[1];
        if (nloc == 0u) { xcd_barrier_complete(bar, b.x, nloc, nx); b.st[0] = nloc; b.st[1] = nx; }
        const unsigned old = xb_add(&bar[XB_XSUB(b.x)], 1u);
        const unsigned gen = old / nloc;
        if (old + 1u == (gen + 1u) * nloc) {
            __builtin_amdgcn_fence(__ATOMIC_RELEASE, "agent");
            asm volatile("s_waitcnt vmcnt(0)" ::: "memory");
            const unsigned og = xb_add(&bar[XB_TOP], 1u);
            const unsigned tg = og / nx;
            if (og + 1u == (tg + 1u) * nx) xb_add(&bar[XB_TOPGEN], 1u);
            else XB_SPIN(xb_ld(&bar[XB_TOPGEN]) == tg, bar);
            __builtin_amdgcn_fence(__ATOMIC_ACQUIRE, "agent");
            xb_add(&bar[XB_XGEN(b.x)], 1u);
            asm volatile("s_waitcnt vmcnt(0)" ::: "memory");
        } else {
            XB_SPIN(xb_ld(&bar[XB_XGEN(b.x)]) == gen, bar);
            __builtin_amdgcn_fence(__ATOMIC_ACQUIRE, "agent");
            asm volatile("s_waitcnt vmcnt(0)" ::: "memory");
        }
    }
    __syncthreads();
}
namespace epi {
using pg8::f32x4; using pg8::u32x4; using pg8::bf16_t; using pg8::Unit;
typedef float f32x2_t __attribute__((ext_vector_type(2))); typedef __bf16 bf16x2_t __attribute__((ext_vector_type(2)));
__device__ __forceinline__ unsigned cvt_pk_bf16(float lo, float hi) { f32x2_t v = {lo, hi}; bf16x2_t b = __builtin_convertvector(v, bf16x2_t); return __builtin_bit_cast(unsigned, b); }
typedef unsigned u32x2 __attribute__((ext_vector_type(2)));
typedef const f32x4 (&Acc)[2][2][4][2];
__device__ __forceinline__ u32x4 pack8(f32x4 a, f32x4 b) { u32x4 w; w.x = cvt_pk_bf16(a[0], a[1]); w.y = cvt_pk_bf16(a[2], a[3]); w.z = cvt_pk_bf16(b[0], b[1]); w.w = cvt_pk_bf16(b[2], b[3]); return w; }
__device__ __forceinline__ f32x4 unpack_lo(unsigned a, unsigned b) { return (f32x4){__uint_as_float(a << 16), __uint_as_float(a & 0xffff0000u), __uint_as_float(b << 16), __uint_as_float(b & 0xffff0000u)}; }
__device__ __forceinline__ float sigmoidf_(float x) { return __builtin_amdgcn_rcpf(1.0f + __builtin_amdgcn_exp2f(-1.4426950408889634f * x)); }
__device__ __forceinline__ f32x4 sig4(f32x4 v) { return (f32x4){sigmoidf_(v[0]), sigmoidf_(v[1]), sigmoidf_(v[2]), sigmoidf_(v[3])}; }
__device__ __forceinline__ int tab_pos(int row) { return row < M_P ? NMETA + (row & (SEQ - 1)) : (row < ROW_M ? LP + ((row - ROW_S) & (DSEQ - 1)) : (row - ROW_M < NMETA ? row - ROW_M : NMETA - 1)); }

struct EpiZ {
    static constexpr bool PERM = true, AFTER_DRAIN = false;
    float* ZF; bf16_t* GB; bf16_t* U; bf16_t* GCV; bf16_t* GML; float* conv_p; float* conv_s;
    __device__ __forceinline__ void operator()(Acc acc, const Unit& u, int wr, int wc, int fr, int fq) const {
        const int pn = u.pn, row0 = u.pm * 256 + wr * 64 + fr, cl = wc * 32 + 8 * fq;
        if (pn < 3) {
#pragma unroll
            for (int ai = 0; ai < 2; ++ai)
#pragma unroll
                for (int m = 0; m < 4; ++m) { float* rp = ZF + (size_t)(row0 + ai * 128 + m * 16) * 768 + pn * 256 + cl;
#pragma unroll
                    for (int bj = 0; bj < 2; ++bj) { *(f32x4*)(rp + bj * 128) = acc[ai][bj][m][0]; *(f32x4*)(rp + bj * 128 + 4) = acc[ai][bj][m][1]; } }
        } else if (pn < 5) {
#pragma unroll
            for (int ai = 0; ai < 2; ++ai)
#pragma unroll
                for (int m = 0; m < 4; ++m) { bf16_t* rp = GB + (size_t)(row0 + ai * 128 + m * 16) * CDIM + (pn - 3) * 256 + cl;
#pragma unroll
                    for (int bj = 0; bj < 2; ++bj) *(u32x4*)(rp + bj * 128) = pack8(acc[ai][bj][m][0], acc[ai][bj][m][1]); }
        } else if (pn < 9) {
            const int cu = (pn - 5) * 128 + cl;
#pragma unroll
            for (int ai = 0; ai < 2; ++ai)
#pragma unroll
                for (int m = 0; m < 4; ++m) { const int row = row0 + ai * 128 + m * 16;
                    const f32x4 u0 = acc[ai][0][m][0] * acc[ai][1][m][0], u1 = acc[ai][0][m][1] * acc[ai][1][m][1];
                    *(u32x4*)(U + (size_t)row * CDIM + cu) = pack8(u0, u1);
                    if (row < M_P) { const int t = row & (SEQ - 1); if (t >= SEQ - 2) { float* o = conv_p + ((size_t)(row >> 11) * 2 + (t - (SEQ - 2))) * CDIM + cu; *(f32x4*)o = u0; *(f32x4*)(o + 4) = u1; } }
                    else if (row < ROW_M) { const int j = (row - ROW_S) & 7; if (j >= 6) { float* o = conv_s + ((size_t)((row - ROW_S) >> 3) * 2 + (j - 6)) * CDIM + cu; *(f32x4*)o = u0; *(f32x4*)(o + 4) = u1; } } }
        } else {
            bf16_t* base = (pn < 13 ? GCV + (pn - 9) * 256 : GML + (pn - 13) * 256) + cl;
#pragma unroll
            for (int ai = 0; ai < 2; ++ai)
#pragma unroll
                for (int m = 0; m < 4; ++m) { bf16_t* rp = base + (size_t)(row0 + ai * 128 + m * 16) * D;
#pragma unroll
                    for (int bj = 0; bj < 2; ++bj) *(u32x4*)(rp + bj * 128) = pack8(sig4(acc[ai][bj][m][0]), sig4(acc[ai][bj][m][1])); }
        }
    }
};
struct EpiQ {
    static constexpr bool PERM = false, AFTER_DRAIN = false;
    bf16_t* Q; const float* tab;
    __device__ __forceinline__ void operator()(Acc acc, const Unit& u, int wr, int wc, int fr, int fq) const {
        const int row0 = u.pm * 256 + wr * 64 + fr;
        const int G0 = u.pn * 8 + wc, G1 = G0 + 4; const bool pe0 = (G0 % 3) == 2, pe1 = (G1 % 3) == 2;
#pragma unroll
        for (int ai = 0; ai < 2; ++ai)
#pragma unroll
            for (int m = 0; m < 4; ++m) { const int row = row0 + ai * 128 + m * 16; bf16_t* rp = Q + (size_t)row * 768 + 4 * fq;
                f32x4 cs = (f32x4){1.f, 1.f, 1.f, 1.f}, sn = (f32x4){0.f, 0.f, 0.f, 0.f};
                if (pe0 || pe1) { const float* tp = tab + (size_t)tab_pos(row) * 32 + 4 * fq; cs = *(const f32x4*)tp; sn = *(const f32x4*)(tp + 16); }
#pragma unroll
                for (int bj = 0; bj < 2; ++bj) { f32x4 a = acc[ai][bj][m][0], b = acc[ai][bj][m][1];
                    if (bj == 0 ? pe0 : pe1) { const f32x4 y1 = a * cs - b * sn, y2 = b * cs + a * sn; a = y1; b = y2; }
                    a = a * QSCALE; b = b * QSCALE;
                    u32x2 w0, w1; w0.x = cvt_pk_bf16(a[0], a[1]); w0.y = cvt_pk_bf16(a[2], a[3]); w1.x = cvt_pk_bf16(b[0], b[1]); w1.y = cvt_pk_bf16(b[2], b[3]);
                    bf16_t* cp = rp + (bj == 0 ? G0 : G1) * 32; *(u32x2*)cp = w0; *(u32x2*)(cp + 16) = w1; }
                asm volatile("" ::: "memory"); }
    }
};
template <int ldc> struct EpiBf16S {
    static constexpr bool PERM = true, AFTER_DRAIN = false;
    bf16_t* O; float s;
    __device__ __forceinline__ void operator()(Acc acc, const Unit& u, int wr, int wc, int fr, int fq) const {
        const int row0 = u.pm * 256 + wr * 64 + fr, col0 = u.pn * 256 + wc * 32 + 8 * fq;
#pragma unroll
        for (int ai = 0; ai < 2; ++ai)
#pragma unroll
            for (int m = 0; m < 4; ++m) { bf16_t* rp = O + (size_t)(row0 + ai * 128 + m * 16) * ldc + col0;
#pragma unroll
                for (int bj = 0; bj < 2; ++bj) *(u32x4*)(rp + bj * 128) = pack8(acc[ai][bj][m][0] * s, acc[ai][bj][m][1] * s); }
    }
};
struct EpiGateT {
    static constexpr bool PERM = true, AFTER_DRAIN = false;
    const bf16_t* G; float* T;
    __device__ __forceinline__ void operator()(Acc acc, const Unit& u, int wr, int wc, int fr, int fq) const {
        const int row0 = u.pm * 256 + wr * 64 + fr, col0 = u.pn * 256 + wc * 32 + 8 * fq;
#pragma unroll
        for (int ai = 0; ai < 2; ++ai)
#pragma unroll
            for (int m = 0; m < 4; ++m) { const size_t off = (size_t)(row0 + ai * 128 + m * 16) * D + col0;
#pragma unroll
                for (int bj = 0; bj < 2; ++bj) { const u32x4 g = *(const u32x4*)(G + off + bj * 128);
                    *(f32x4*)(T + off + bj * 128) = unpack_lo(g.x, g.y) * acc[ai][bj][m][0]; *(f32x4*)(T + off + bj * 128 + 4) = unpack_lo(g.z, g.w) * acc[ai][bj][m][1]; } }
    }
};
struct EpiMix {
    static constexpr bool PERM = true, AFTER_DRAIN = false;
    const bf16_t* G; const float* T; bf16_t* O;
    __device__ __forceinline__ void operator()(Acc acc, const Unit& u, int wr, int wc, int fr, int fq) const {
        const int row0 = u.pm * 256 + wr * 64 + fr, col0 = u.pn * 256 + wc * 32 + 8 * fq;
#pragma unroll
        for (int ai = 0; ai < 2; ++ai)
#pragma unroll
            for (int m = 0; m < 4; ++m) { const size_t off = (size_t)(row0 + ai * 128 + m * 16) * D + col0;
#pragma unroll
                for (int bj = 0; bj < 2; ++bj) { const u32x4 g = *(const u32x4*)(G + off + bj * 128); const f32x4 t0 = *(const f32x4*)(T + off + bj * 128), t1 = *(const f32x4*)(T + off + bj * 128 + 4);
                    *(u32x4*)(O + off + bj * 128) = pack8(t0 + unpack_lo(g.x, g.y) * acc[ai][bj][m][0], t1 + unpack_lo(g.z, g.w) * acc[ai][bj][m][1]); } }
    }
};
struct EpiRes {
    static constexpr bool PERM = true, AFTER_DRAIN = false;
    const float* res; float* R;
    __device__ __forceinline__ void operator()(Acc acc, const Unit& u, int wr, int wc, int fr, int fq) const {
        const int row0 = u.pm * 256 + wr * 64 + fr, col0 = u.pn * 256 + wc * 32 + 8 * fq;
#pragma unroll
        for (int ai = 0; ai < 2; ++ai)
#pragma unroll
            for (int m = 0; m < 4; ++m) { const size_t off = (size_t)(row0 + ai * 128 + m * 16) * D + col0;
#pragma unroll
                for (int bj = 0; bj < 2; ++bj) { const f32x4 r0 = *(const f32x4*)(res + off + bj * 128), r1 = *(const f32x4*)(res + off + bj * 128 + 4);
                    *(f32x4*)(R + off + bj * 128) = r0 * ALPHA + acc[ai][bj][m][0]; *(f32x4*)(R + off + bj * 128 + 4) = r1 * ALPHA + acc[ai][bj][m][1]; } }
    }
};
struct EpiRelu2 {
    static constexpr bool PERM = true, AFTER_DRAIN = false;
    bf16_t* O;
    __device__ __forceinline__ void operator()(Acc acc, const Unit& u, int wr, int wc, int fr, int fq) const {
        const int row0 = u.pm * 256 + wr * 64 + fr, col0 = u.pn * 256 + wc * 32 + 8 * fq;
#pragma unroll
        for (int ai = 0; ai < 2; ++ai)
#pragma unroll
            for (int m = 0; m < 4; ++m) { bf16_t* rp = O + (size_t)(row0 + ai * 128 + m * 16) * FF + col0;
#pragma unroll
                for (int bj = 0; bj < 2; ++bj) { f32x4 a = acc[ai][bj][m][0], b = acc[ai][bj][m][1];
#pragma unroll
                    for (int i = 0; i < 4; ++i) { a[i] = a[i] > 0.f ? a[i] * a[i] : 0.f; b[i] = b[i] > 0.f ? b[i] * b[i] : 0.f; }
                    *(u32x4*)(rp + bj * 128) = pack8(a, b); } }
    }
};
}
struct Frame {
    LAS unsigned char* lds;
    volatile LAS unsigned* MISC;
    gu32* ctl;
    int tid, lane, wave;
    int vcu, G;
    const float *x_prompt, *x_sample, *cache_ckv, *cache_kpe, *state_conv; const int* page_table; const float *meta, *lne_g, *lne_b, *w_in, *qn_g, *w_uq, *kvn_g, *w_uk, *w_uv, *w_o_mla,
        *conv_w, *w_conv_out, *w_o, *ln1_g, *ln1_b, *w_up, *w_down, *ln2_g, *ln2_b;
    float* out; unsigned char* ws;
};
#define WSP(T, off) ((T*)(F.ws + (off)))

__device__ __forceinline__ float wave_sum(float v) {
#pragma unroll
    for (int o = 1; o < 64; o <<= 1) v += __shfl_xor(v, o);
    return v;
}
__device__ __forceinline__ float bf2f(unsigned short h) { return __uint_as_float((unsigned)h << 16); }
__device__ __forceinline__ float bflo(unsigned u) { return __uint_as_float(u << 16); }
__device__ __forceinline__ float bfhi(unsigned u) { return __uint_as_float(u & 0xffff0000u); }

__device__ __forceinline__ void p0_transpose_item(const float* W, int ldw, bf16* WT, int ldt, int k0, int srcn0, int dstn0, LAS float* scr, int lane) {
    if (srcn0 >= 0) {
#pragma unroll 8
        for (int i = 0; i < 32; ++i) { const int kk = 2 * i + (lane >> 5); scr[kk * 33 + (lane & 31)] = W[(size_t)(k0 + kk) * ldw + srcn0 + (lane & 31)]; }
    } else {
#pragma unroll 8
        for (int i = 0; i < 32; ++i) { const int kk = 2 * i + (lane >> 5); scr[kk * 33 + (lane & 31)] = 0.f; }
    }
    LDS_WAIT(); asm volatile("" ::: "memory");
    const int c = lane & 7;
#pragma unroll
    for (int j = 0; j < 4; ++j) { const int n = (lane >> 3) + 8 * j; const LAS float* s = scr + (8 * c) * 33 + n;
        v4u o; o.x = pk2(s[0 * 33], s[1 * 33]); o.y = pk2(s[2 * 33], s[3 * 33]); o.z = pk2(s[4 * 33], s[5 * 33]); o.w = pk2(s[6 * 33], s[7 * 33]);
        *(GAS v4u*)(WT + (size_t)(dstn0 + n) * ldt + k0 + 8 * c) = o; }
    LDS_WAIT(); asm volatile("" ::: "memory");
}
__device__ __forceinline__ int win_src_col(int n) {
    if (n < 384) return ZC_CQ + n;
    if (n < 416) return ZC_KPE + (n - 384);
    if (n < 512) return -1;
    if (n < 768) return ZC_CKV + (n - 512);
    if (n < 1280) return ZC_GB + (n - 768);
    if (n < 2304) { const int q = n - 1280, p = q >> 8, j = q & 255; return j < 128 ? ZC_GC + 128 * p + j : ZC_CH + 128 * p + (j - 128); }
    if (n < 3328) return ZC_GCV + (n - 2304);
    return ZC_GML + (n - 3328);
}
__device__ __forceinline__ void sincos_d(double a, double& s, double& c) {
    const double n = __builtin_rint(a * 0.63661977236758138);
    double r = __builtin_fma(-n, 1.5707963267948966, a); r = __builtin_fma(-n, 6.123233995736766e-17, r);
    const double r2 = r * r;
    double sp = -1.0 / 1307674368000.0; sp = sp * r2 + 1.0 / 6227020800.0; sp = sp * r2 - 1.0 / 39916800.0; sp = sp * r2 + 1.0 / 362880.0; sp = sp * r2 - 1.0 / 5040.0; sp = sp * r2 + 1.0 / 120.0; sp = sp * r2 - 1.0 / 6.0; sp = sp * r2 + 1.0; sp *= r;
    double cp = 1.0 / 20922789888000.0; cp = cp * r2 - 1.0 / 87178291200.0; cp = cp * r2 + 1.0 / 479001600.0; cp = cp * r2 - 1.0 / 3628800.0; cp = cp * r2 + 1.0 / 40320.0; cp = cp * r2 - 1.0 / 720.0; cp = cp * r2 + 1.0 / 24.0; cp = cp * r2 - 0.5; cp = cp * r2 + 1.0;
    const int q = ((int)n) & 3;
    s = (q == 0) ? sp : (q == 1) ? cp : (q == 2) ? -sp : -cp;
    c = (q == 0) ? cp : (q == 1) ? -sp : (q == 2) ? -cp : sp;
}
__device__ __forceinline__ void ln_row(f32x4 (&v)[4], const float* g, const float* b, int lane) {
    float s = 0.f;
#pragma unroll
    for (int j = 0; j < 4; ++j) s += (v[j].x + v[j].y) + (v[j].z + v[j].w);
    const float mean = wave_sum(s) * (1.f / D); float s2 = 0.f;
#pragma unroll
    for (int j = 0; j < 4; ++j) { v[j] = v[j] - mean; s2 += (v[j].x * v[j].x + v[j].y * v[j].y) + (v[j].z * v[j].z + v[j].w * v[j].w); }
    const float rstd = 1.f / sqrtf(wave_sum(s2) * (1.f / D) + LN_EPS);
#pragma unroll
    for (int j = 0; j < 4; ++j) { const f32x4 gg = *(const f32x4*)(g + 4 * lane + 256 * j), bb = *(const f32x4*)(b + 4 * lane + 256 * j); v[j] = v[j] * rstd * gg + bb; }
}

__device__ __forceinline__ void p0_prologue(Frame& F) {
    LAS float* scr = (LAS float*)(F.lds + RING_OFF + F.wave * 16384);
    const int gw = F.vcu * NWAVES + F.wave, NGW = F.G * NWAVES, lane = F.lane;
    constexpr int I_IN = (D / 64) * (NZ / 32), I_UQ = (QLORA / 64) * (768 / 32), I_KV = (KVL / 64) * (1024 / 32), I_CO = (CDIM / 64) * (D / 32), I_OM = (512 / 64) * (D / 32),
                  I_O = (D / 64) * (D / 32), I_UP = (D / 64) * (FF / 32), I_DN = (FF / 64) * (D / 32);
    constexpr int NITEMS = I_IN + I_UQ + I_KV + I_CO + I_OM + I_O + I_UP + I_DN;
    for (int it = gw; it < NITEMS; it += NGW) {
        int r = it;
        if (r < I_IN) { const int nb = r % (NZ / 32), kb = r / (NZ / 32); p0_transpose_item(F.w_in, DIN, WSP(bf16, WS_WIN), D, 64 * kb, win_src_col(32 * nb), 32 * nb, scr, lane); continue; } r -= I_IN;
        if (r < I_UQ) { const int nb = r % 24, kb = r / 24; p0_transpose_item(F.w_uq, 768, WSP(bf16, WS_WUQ), QLORA, 64 * kb, 32 * nb, 32 * nb, scr, lane); continue; } r -= I_UQ;
        if (r < I_KV) { const int nb = r % 32, kb = r / 32; p0_transpose_item(nb < 16 ? F.w_uk : F.w_uv, 512, WSP(bf16, WS_WKV), KVL, 64 * kb, 32 * (nb & 15), 32 * nb, scr, lane); continue; } r -= I_KV;
        if (r < I_CO) { const int nb = r % 32, kb = r / 32; p0_transpose_item(F.w_conv_out, D, WSP(bf16, WS_WCO), CDIM, 64 * kb, 32 * nb, 32 * nb, scr, lane); continue; } r -= I_CO;
        if (r < I_OM) { const int nb = r % 32, kb = r / 32; p0_transpose_item(F.w_o_mla, D, WSP(bf16, WS_WOM), 512, 64 * kb, 32 * nb, 32 * nb, scr, lane); continue; } r -= I_OM;
        if (r < I_O) { const int nb = r % 32, kb = r / 32; p0_transpose_item(F.w_o, D, WSP(bf16, WS_WO), D, 64 * kb, 32 * nb, 32 * nb, scr, lane); continue; } r -= I_O;
        if (r < I_UP) { const int nb = r % 128, kb = r / 128; p0_transpose_item(F.w_up, FF, WSP(bf16, WS_WUP), D, 64 * kb, 32 * nb, 32 * nb, scr, lane); continue; } r -= I_UP;
        { const int nb = r % 32, kb = r / 32; p0_transpose_item(F.w_down, D, WSP(bf16, WS_WDN), FF, 64 * kb, 32 * nb, 32 * nb, scr, lane); }
    }
    for (int n = gw; n < NH * KVL; n += NGW) {
        const int h = n >> 8, c = n & 255; const float* uk = F.w_uk + (size_t)c * 512 + h * 64;
        bf16* dst = WSP(bf16, WS_WABS) + (size_t)n * QLORA;
        for (int j = 0; j < QLORA / 64; ++j) { const int k = lane + 64 * j; const float* uq = F.w_uq + (size_t)k * 768 + h * 96; float s = 0.f;
#pragma unroll 4
            for (int i = 0; i < 16; ++i) { const f32x4 a = *(const f32x4*)(uq + 4 * i), b = *(const f32x4*)(uk + 4 * i); s += (a.x * b.x + a.y * b.y) + (a.z * b.z + a.w * b.w); }
            dst[k] = (bf16)f2bf(s); }
    }
    for (int e = F.vcu * (NWAVES * 64) + F.tid; e < NTAB * 16; e += F.G * NWAVES * 64) {
        const int tp = e >> 4, i = e & 15; const int pos = tp < LP ? tp : PAST + (tp - LP);
        double inv = 1.0; for (int j = 0; j < i; ++j) inv *= 0.56234132519034908;
        const float inv_f = (float)inv; const float ang = (float)pos * inv_f;
        double s, c; sincos_d((double)ang, s, c);
        float* t = WSP(float, WS_TAB) + (size_t)tp * 32; t[i] = (float)c; t[16 + i] = (float)s;
    }
    for (int m = gw; m < M_ALL; m += NGW) {
        GAS unsigned long long* o8 = (GAS unsigned long long*)(WSP(bf16, WS_XN) + (size_t)m * D) + lane;
        GAS f32x4* h4 = (GAS f32x4*)(WSP(float, WS_H32) + (size_t)m * D) + lane;
        if (m >= ROW_M + NMETA) {
#pragma unroll
            for (int j = 0; j < 4; ++j) { o8[64 * j] = 0ull; h4[64 * j] = (f32x4){0.f, 0.f, 0.f, 0.f}; }
            continue; }
        const float* xrow = m < M_P ? F.x_prompt + (size_t)m * D : (m < ROW_M ? F.x_sample + (size_t)(m - ROW_S) * D : F.meta + (size_t)(m - ROW_M) * D);
        const GAS f32x4* xr = (const GAS f32x4*)xrow + lane;
        f32x4 v[4];
#pragma unroll
        for (int j = 0; j < 4; ++j) v[j] = xr[64 * j];
        ln_row(v, F.lne_g, F.lne_b, lane);
#pragma unroll
        for (int j = 0; j < 4; ++j) { h4[64 * j] = v[j]; o8[64 * j] = (unsigned long long)pk2(v[j].x, v[j].y) | ((unsigned long long)pk2(v[j].z, v[j].w) << 32); }
    }
}

__device__ __forceinline__ void p2_thin(Frame& F) {
    const int gw = F.vcu * NWAVES + F.wave, NGW = F.G * NWAVES, lane = F.lane;
    const float* ZF = WSP(float, WS_ZF); const bf16* GB = WSP(bf16, WS_GB); const bf16* U = WSP(bf16, WS_U);
    for (int m = gw; m < ROW_M + NMETA; m += NGW) {
        const float* z = ZF + (size_t)m * 768;
        { const f32x4 a = *(const f32x4*)(z + 4 * lane); const float b0 = z[256 + 2 * lane], b1 = z[256 + 2 * lane + 1];
          const float ss = wave_sum((a.x * a.x + a.y * a.y) + (a.z * a.z + a.w * a.w) + (b0 * b0 + b1 * b1));
          const float sc = 1.f / sqrtf(ss * (1.f / QLORA) + RMS_EPS);
          const f32x4 g = *(const f32x4*)(F.qn_g + 4 * lane); const float g0 = F.qn_g[256 + 2 * lane], g1 = F.qn_g[256 + 2 * lane + 1];
          bf16* o = WSP(bf16, WS_CQN) + (size_t)m * QLORA;
          *(unsigned long long*)(o + 4 * lane) = (unsigned long long)pk2(a.x * sc * g.x, a.y * sc * g.y) | ((unsigned long long)pk2(a.z * sc * g.z, a.w * sc * g.w) << 32);
          *(unsigned*)(o + 256 + 2 * lane) = pk2(b0 * sc * g0, b1 * sc * g1); }
        { const f32x4 a = *(const f32x4*)(z + 512 + 4 * lane);
          const float ss = wave_sum((a.x * a.x + a.y * a.y) + (a.z * a.z + a.w * a.w));
          const float sc = 1.f / sqrtf(ss * (1.f / KVL) + RMS_EPS);
          const f32x4 g = *(const f32x4*)(F.kvn_g + 4 * lane); const f32x4 v = a * sc * g;
          *(unsigned long long*)(WSP(bf16, WS_CKV) + (size_t)m * KVL + 4 * lane) = (unsigned long long)pk2(v.x, v.y) | ((unsigned long long)pk2(v.z, v.w) << 32);
          if (m < M_P) *(f32x4*)(F.out + O_CKVP + ((size_t)(m >> 11) * LP + NMETA + (m & (SEQ - 1))) * KVL + 4 * lane) = v;
          else if (m < ROW_M) *(f32x4*)(F.out + O_CKVS + (size_t)(m - ROW_S) * KVL + 4 * lane) = v;
          else for (int b = 0; b < NB; ++b) *(f32x4*)(F.out + O_CKVP + ((size_t)b * LP + (m - ROW_M)) * KVL + 4 * lane) = v; }
        if (lane < 16) { const float x1 = z[384 + lane], x2 = z[384 + 16 + lane]; const float* t = WSP(float, WS_TAB) + (size_t)epi::tab_pos(m) * 32; const float cs = t[lane], sn = t[16 + lane];
          const float y1 = x1 * cs - x2 * sn, y2 = x2 * cs + x1 * sn;
          bf16* o = WSP(bf16, WS_KPE) + (size_t)m * ROPE; o[lane] = (bf16)f2bf(y1); o[16 + lane] = (bf16)f2bf(y2);
          if (m < M_P) { float* p = F.out + O_KPEP + ((size_t)(m >> 11) * LP + NMETA + (m & (SEQ - 1))) * ROPE; p[lane] = y1; p[16 + lane] = y2; }
          else if (m < ROW_M) { float* p = F.out + O_KPES + (size_t)(m - ROW_S) * ROPE; p[lane] = y1; p[16 + lane] = y2; }
          else for (int b = 0; b < NB; ++b) { float* p = F.out + O_KPEP + ((size_t)b * LP + (m - ROW_M)) * ROPE; p[lane] = y1; p[16 + lane] = y2; } }
        if (m < ROW_M) {
            const int c0 = 8 * lane; float u0[8], u1[8], u2[8];
            { const v4u r = *(const v4u*)(U + (size_t)m * CDIM + c0); u0[0] = bflo(r.x); u0[1] = bfhi(r.x); u0[2] = bflo(r.y); u0[3] = bfhi(r.y); u0[4] = bflo(r.z); u0[5] = bfhi(r.z); u0[6] = bflo(r.w); u0[7] = bfhi(r.w); }
#pragma unroll
            for (int d = 1; d <= 2; ++d) { float* dst = d == 1 ? u1 : u2; int src = -1; const float* st = nullptr;
                if (m < M_P) { const int t = m & (SEQ - 1); src = t >= d ? m - d : ROW_M + NMETA - (d - t); }
                else { const int j = (m - ROW_S) & 7, db = (m - ROW_S) >> 3; if (j >= d) src = m - d; else st = F.state_conv + ((size_t)db * 2 + (2 - (d - j))) * CDIM; }
                if (src >= 0) { const v4u r = *(const v4u*)(U + (size_t)src * CDIM + c0); dst[0] = bflo(r.x); dst[1] = bfhi(r.x); dst[2] = bflo(r.y); dst[3] = bfhi(r.y); dst[4] = bflo(r.z); dst[5] = bfhi(r.z); dst[6] = bflo(r.w); dst[7] = bfhi(r.w); }
                else { const f32x4 a = *(const f32x4*)(st + c0), b = *(const f32x4*)(st + c0 + 4); dst[0] = a.x; dst[1] = a.y; dst[2] = a.z; dst[3] = a.w; dst[4] = b.x; dst[5] = b.y; dst[6] = b.z; dst[7] = b.w; } }
            const v4u gr = *(const v4u*)(GB + (size_t)m * CDIM + c0); float gb[8] = {bflo(gr.x), bfhi(gr.x), bflo(gr.y), bfhi(gr.y), bflo(gr.z), bfhi(gr.z), bflo(gr.w), bfhi(gr.w)};
            float r[8];
#pragma unroll
            for (int e = 0; e < 8; ++e) { const float w0 = F.conv_w[c0 + e], w1 = F.conv_w[CDIM + c0 + e], w2 = F.conv_w[2 * CDIM + c0 + e]; r[e] = gb[e] * (w0 * u2[e] + w1 * u1[e] + w2 * u0[e]); }
            v4u o; o.x = pk2(r[0], r[1]); o.y = pk2(r[2], r[3]); o.z = pk2(r[4], r[5]); o.w = pk2(r[6], r[7]);
            *(v4u*)(WSP(bf16, WS_CV) + (size_t)m * CDIM + c0) = o;
        }
    }
}

__device__ __forceinline__ void attn_prompt_naive(Frame& F) {
    const bf16* Q = WSP(bf16, WS_Q); const bf16* KV = WSP(bf16, WS_KV); const bf16* KPE = WSP(bf16, WS_KPE); bf16* O = WSP(bf16, WS_O);
    for (int v = blockIdx.x; v < 256; v += F.G) {
        const int bh = v >> 1, b = bh >> 3, h = bh & 7;
        for (int ii = 0; ii < 2; ++ii) {
            const int qblk = (v & 1) ? (1 + ii) : (3 * ii);
            const int t = qblk * 512 + F.tid; const size_t row = (size_t)b * SEQ + t;
            float q[QHD], o[VHD]; float mx = -INFINITY, l = 0.f;
            { const v4u* qp = (const v4u*)(Q + row * 768 + h * QHD);
#pragma unroll
              for (int i = 0; i < QHD / 8; ++i) { const v4u r = qp[i]; q[8 * i] = bflo(r.x); q[8 * i + 1] = bfhi(r.x); q[8 * i + 2] = bflo(r.y); q[8 * i + 3] = bfhi(r.y); q[8 * i + 4] = bflo(r.z); q[8 * i + 5] = bfhi(r.z); q[8 * i + 6] = bflo(r.w); q[8 * i + 7] = bfhi(r.w); } }
#pragma unroll
            for (int d = 0; d < VHD; ++d) o[d] = 0.f;
            const int tmax = qblk * 512 + F.wave * 64 + 63;
            for (int kk = -NMETA; kk <= tmax; ++kk) {
                const size_t krow = kk < 0 ? (size_t)(ROW_M + NMETA + kk) : (size_t)b * SEQ + kk;
                const v4u* kp = (const v4u*)(KV + krow * 1024 + h * NOPE); const v4u* pp = (const v4u*)(KPE + krow * ROPE); const v4u* vp = (const v4u*)(KV + krow * 1024 + 512 + h * VHD);
                float s = 0.f;
#pragma unroll
                for (int i = 0; i < 8; ++i) { const v4u r = kp[i]; s += q[8 * i] * bflo(r.x) + q[8 * i + 1] * bfhi(r.x) + q[8 * i + 2] * bflo(r.y) + q[8 * i + 3] * bfhi(r.y) + q[8 * i + 4] * bflo(r.z) + q[8 * i + 5] * bfhi(r.z) + q[8 * i + 6] * bflo(r.w) + q[8 * i + 7] * bfhi(r.w); }
#pragma unroll
                for (int i = 0; i < 4; ++i) { const v4u r = pp[i]; const int j = 64 + 8 * i; s += q[j] * bflo(r.x) + q[j + 1] * bfhi(r.x) + q[j + 2] * bflo(r.y) + q[j + 3] * bfhi(r.y) + q[j + 4] * bflo(r.z) + q[j + 5] * bfhi(r.z) + q[j + 6] * bflo(r.w) + q[j + 7] * bfhi(r.w); }
                if (kk <= t) {
                    if (s > mx) { const float a = __builtin_amdgcn_exp2f(mx - s); l *= a;
#pragma unroll
                        for (int d = 0; d < VHD; ++d) o[d] *= a;
                        mx = s; }
                    const float p = __builtin_amdgcn_exp2f(s - mx); l += p;
#pragma unroll
                    for (int i = 0; i < 8; ++i) { const v4u r = vp[i]; o[8 * i] += p * bflo(r.x); o[8 * i + 1] += p * bfhi(r.x); o[8 * i + 2] += p * bflo(r.y); o[8 * i + 3] += p * bfhi(r.y); o[8 * i + 4] += p * bflo(r.z); o[8 * i + 5] += p * bfhi(r.z); o[8 * i + 6] += p * bflo(r.w); o[8 * i + 7] += p * bfhi(r.w); }
                }
            }
            const float il = 1.f / l; v4u* op = (v4u*)(O + row * 512 + h * VHD);
#pragma unroll
            for (int i = 0; i < 8; ++i) { v4u w; w.x = pk2(o[8 * i] * il, o[8 * i + 1] * il); w.y = pk2(o[8 * i + 2] * il, o[8 * i + 3] * il); w.z = pk2(o[8 * i + 4] * il, o[8 * i + 5] * il); w.w = pk2(o[8 * i + 6] * il, o[8 * i + 7] * il); op[i] = w; }
        }
    }
}

__device__ __forceinline__ void attn_decode_naive(Frame& F) {
    const bf16* Q = WSP(bf16, WS_Q); const bf16* QLAT = WSP(bf16, WS_QLAT); const bf16* CKV = WSP(bf16, WS_CKV); const bf16* KPE = WSP(bf16, WS_KPE); float* PART = WSP(float, WS_PART);
    const int r = F.tid >> 3, part = F.tid & 7, j = r >> 3, h = r & 7;
    for (int uu = blockIdx.x; uu < DBATCH * NSPLIT; uu += F.G) {
        const int db = uu / NSPLIT, ck = uu % NSPLIT;
        float ql[32], qp[4], o[32]; float mx = -INFINITY, l = 0.f;
        { const v4u* p = (const v4u*)(QLAT + (size_t)(db * DSEQ + j) * 2048 + h * KVL + part * 32);
#pragma unroll
          for (int i = 0; i < 4; ++i) { const v4u w = p[i]; ql[8 * i] = bflo(w.x); ql[8 * i + 1] = bfhi(w.x); ql[8 * i + 2] = bflo(w.y); ql[8 * i + 3] = bfhi(w.y); ql[8 * i + 4] = bflo(w.z); ql[8 * i + 5] = bfhi(w.z); ql[8 * i + 6] = bflo(w.w); ql[8 * i + 7] = bfhi(w.w); }
          const unsigned long long w = *(const unsigned long long*)(Q + (size_t)(ROW_S + db * DSEQ + j) * 768 + h * QHD + NOPE + part * 4);
          qp[0] = bflo((unsigned)w); qp[1] = bfhi((unsigned)w); qp[2] = bflo((unsigned)(w >> 32)); qp[3] = bfhi((unsigned)(w >> 32)); }
#pragma unroll
        for (int d = 0; d < 32; ++d) o[d] = 0.f;
        const int npg = NPG / NSPLIT;
        for (int pg = ck * npg; pg < (ck + 1) * npg; ++pg) {
            const int phys = F.page_table[db * NPG + pg];
            const float* cb = F.cache_ckv + (size_t)phys * PAGE * KVL + part * 32; const float* pb = F.cache_kpe + (size_t)phys * PAGE * ROPE + part * 4;
            for (int kk = 0; kk < PAGE; ++kk) {
                float kv[32]; const f32x4* cp = (const f32x4*)(cb + (size_t)kk * KVL);
#pragma unroll
                for (int i = 0; i < 8; ++i) { const f32x4 w = cp[i]; kv[4 * i] = w.x; kv[4 * i + 1] = w.y; kv[4 * i + 2] = w.z; kv[4 * i + 3] = w.w; }
                const f32x4 kp = *(const f32x4*)(pb + (size_t)kk * ROPE);
                float s = qp[0] * kp.x + qp[1] * kp.y + qp[2] * kp.z + qp[3] * kp.w;
#pragma unroll
                for (int d = 0; d < 32; ++d) s += ql[d] * kv[d];
                s += __shfl_xor(s, 1); s += __shfl_xor(s, 2); s += __shfl_xor(s, 4);
                if (s > mx) { const float a = __builtin_amdgcn_exp2f(mx - s); l *= a;
#pragma unroll
                    for (int d = 0; d < 32; ++d) o[d] *= a;
                    mx = s; }
                const float p = __builtin_amdgcn_exp2f(s - mx); l += p;
#pragma unroll
                for (int d = 0; d < 32; ++d) o[d] += p * kv[d];
            }
        }
        if (ck == NSPLIT - 1) {
            for (int jj = 0; jj < DSEQ; ++jj) {
                const size_t krow = (size_t)ROW_S + db * DSEQ + jj; float kv[32];
                const v4u* cp = (const v4u*)(CKV + krow * KVL + part * 32);
#pragma unroll
                for (int i = 0; i < 4; ++i) { const v4u w = cp[i]; kv[8 * i] = bflo(w.x); kv[8 * i + 1] = bfhi(w.x); kv[8 * i + 2] = bflo(w.y); kv[8 * i + 3] = bfhi(w.y); kv[8 * i + 4] = bflo(w.z); kv[8 * i + 5] = bfhi(w.z); kv[8 * i + 6] = bflo(w.w); kv[8 * i + 7] = bfhi(w.w); }
                const unsigned long long w = *(const unsigned long long*)(KPE + krow * ROPE + part * 4);
                float s = qp[0] * bflo((unsigned)w) + qp[1] * bfhi((unsigned)w) + qp[2] * bflo((unsigned)(w >> 32)) + qp[3] * bfhi((unsigned)(w >> 32));
#pragma unroll
                for (int d = 0; d < 32; ++d) s += ql[d] * kv[d];
                s += __shfl_xor(s, 1); s += __shfl_xor(s, 2); s += __shfl_xor(s, 4);
                if (jj <= j) {
                    if (s > mx) { const float a = __builtin_amdgcn_exp2f(mx - s); l *= a;
#pragma unroll
                        for (int d = 0; d < 32; ++d) o[d] *= a;
                        mx = s; }
                    const float p = __builtin_amdgcn_exp2f(s - mx); l += p;
#pragma unroll
                    for (int d = 0; d < 32; ++d) o[d] += p * kv[d];
                }
            }
        }
        float* dst = PART + ((size_t)(db * NSPLIT + ck) * 64 + r) * 264;
#pragma unroll
        for (int i = 0; i < 8; ++i) *(f32x4*)(dst + part * 32 + 4 * i) = (f32x4){o[4 * i], o[4 * i + 1], o[4 * i + 2], o[4 * i + 3]};
        if (part == 0) { dst[256] = mx; dst[257] = l; }
    }
}

__device__ __forceinline__ void decode_combine(Frame& F) {
    const float* PART = WSP(float, WS_PART); bf16* O = WSP(bf16, WS_O);
    LAS float* OL = (LAS float*)(F.lds + RING_OFF);
    const int r = F.tid >> 3, part = F.tid & 7, j = r >> 3, h = r & 7;
    for (int db = blockIdx.x; db < DBATCH; db += F.G) {
        const float* src0 = PART + ((size_t)db * NSPLIT * 64 + r) * 264;
        float M = -INFINITY;
#pragma unroll 1
        for (int k = 0; k < NSPLIT; ++k) M = fmaxf(M, src0[(size_t)k * 64 * 264 + 256]);
        float L = 0.f, o[32];
#pragma unroll
        for (int d = 0; d < 32; ++d) o[d] = 0.f;
#pragma unroll 1
        for (int k = 0; k < NSPLIT; ++k) { const float* src = src0 + (size_t)k * 64 * 264; const float a = __builtin_amdgcn_exp2f(src[256] - M); L += src[257] * a;
#pragma unroll
            for (int i = 0; i < 8; ++i) { const f32x4 w = *(const f32x4*)(src + part * 32 + 4 * i); o[4 * i] += a * w.x; o[4 * i + 1] += a * w.y; o[4 * i + 2] += a * w.z; o[4 * i + 3] += a * w.w; } }
        const float il = 1.f / L;
#pragma unroll
        for (int d = 0; d < 32; ++d) OL[r * 260 + part * 32 + d] = o[d] * il;
        __syncthreads();
        float acc[8];
#pragma unroll
        for (int e = 0; e < 8; ++e) acc[e] = 0.f;
        const float* wv = F.w_uv + h * VHD + part * 8;
        for (int c = 0; c < KVL; ++c) { const float x = OL[r * 260 + c]; const f32x4 a = *(const f32x4*)(wv + (size_t)c * 512), b = *(const f32x4*)(wv + (size_t)c * 512 + 4);
            acc[0] += x * a.x; acc[1] += x * a.y; acc[2] += x * a.z; acc[3] += x * a.w; acc[4] += x * b.x; acc[5] += x * b.y; acc[6] += x * b.z; acc[7] += x * b.w; }
        v4u w; w.x = pk2(acc[0], acc[1]); w.y = pk2(acc[2], acc[3]); w.z = pk2(acc[4], acc[5]); w.w = pk2(acc[6], acc[7]);
        *(v4u*)(O + (size_t)(ROW_S + db * DSEQ + j) * 512 + h * VHD + part * 8) = w;
        __syncthreads();
    }
}

__device__ __forceinline__ void ln_pass(Frame& F, const float* R, const float* g, const float* b, float* dst32, bf16* dst16, int nrows) {
    const int gw = F.vcu * NWAVES + F.wave, NGW = F.G * NWAVES, lane = F.lane;
    for (int m = gw; m < nrows; m += NGW) {
        const GAS f32x4* xr = (const GAS f32x4*)(R + (size_t)m * D) + lane; f32x4 v[4];
#pragma unroll
        for (int j = 0; j < 4; ++j) v[j] = xr[64 * j];
        ln_row(v, g, b, lane);
        GAS f32x4* o4 = (GAS f32x4*)(dst32 + (size_t)m * D) + lane;
#pragma unroll
        for (int j = 0; j < 4; ++j) o4[64 * j] = v[j];
        if (dst16) { GAS unsigned long long* o8 = (GAS unsigned long long*)(dst16 + (size_t)m * D) + lane;
#pragma unroll
            for (int j = 0; j < 4; ++j) o8[64 * j] = (unsigned long long)pk2(v[j].x, v[j].y) | ((unsigned long long)pk2(v[j].z, v[j].w) << 32); }
    }
}
#ifndef MK_N_LAUNCHES
#define MK_N_LAUNCHES 1
#endif
constexpr int NPHASE = 13;
struct Args { const void* in[25]; float* out; unsigned char* ws; int ph_lo, ph_hi; };
__global__ void __launch_bounds__(NWAVES * 64, 2) fwd_kernel(Args args) {
    extern __shared__ __attribute__((aligned(16))) unsigned char lds[];
    Frame F;
    F.lds = (LAS unsigned char*)lds;
    F.MISC = (volatile LAS unsigned*)(F.lds + MISC_OFF);
    F.tid = threadIdx.x; F.lane = F.tid & 63; F.wave = __builtin_amdgcn_readfirstlane(F.tid >> 6);
    F.G = gridDim.x; { const int bx = blockIdx.x; F.vcu = (F.G % 8 == 0) ? (bx % 8) * (F.G / 8) + bx / 8 : bx; }
    F.ws = args.ws; F.out = args.out; F.ctl = (gu32*)(args.ws + WS_CTL);
    F.x_prompt = (const float*)args.in[0]; F.x_sample = (const float*)args.in[1]; F.cache_ckv = (const float*)args.in[2]; F.cache_kpe = (const float*)args.in[3]; F.state_conv = (const float*)args.in[4];
    F.page_table = (const int*)args.in[5]; F.meta = (const float*)args.in[6]; F.lne_g = (const float*)args.in[7]; F.lne_b = (const float*)args.in[8]; F.w_in = (const float*)args.in[9];
    F.qn_g = (const float*)args.in[10]; F.w_uq = (const float*)args.in[11]; F.kvn_g = (const float*)args.in[12]; F.w_uk = (const float*)args.in[13]; F.w_uv = (const float*)args.in[14];
    F.w_o_mla = (const float*)args.in[15]; F.conv_w = (const float*)args.in[16]; F.w_conv_out = (const float*)args.in[17]; F.w_o = (const float*)args.in[18]; F.ln1_g = (const float*)args.in[19];
    F.ln1_b = (const float*)args.in[20]; F.w_up = (const float*)args.in[21]; F.w_down = (const float*)args.in[22]; F.ln2_g = (const float*)args.in[23]; F.ln2_b = (const float*)args.in[24];
    for (int u = F.tid; u < (LDS_BYTES - LDSCTL_OFF) / 4; u += NWAVES * 64) ((LAS unsigned*)(F.lds + LDSCTL_OFF))[u] = 0u;
    __syncthreads();
    const int lo = args.ph_lo, hi = args.ph_hi;
    const bool one_phase = (hi - lo) == 1;
    XcdBarrier bar; bar.bar = (unsigned*)(F.ctl + CW_BAR); bar.x = 0; bar.st = nullptr;
    if (!one_phase) bar = xcd_barrier_post((unsigned*)(F.ctl + CW_BAR), F.MISC + 8);
#ifndef PH_MASK
#define PH_MASK 0xFFFFFFFFu
#endif
#define IN(k) ((((PH_MASK) >> (k)) & 1u) && lo <= (k) && (k) < hi)
#define SEAM(k) do { if (IN(k) && IN((k) + 1)) xcd_barrier(bar); } while (0)
    using pg8::bf16_t;
    if (IN(0)) { p0_prologue(F); SEAM(0); }
    if (IN(1)) {
        pg8::Gemm g{WSP(bf16_t, WS_XN), WSP(bf16_t, WS_WIN), M_ALL, NZ, D}; pg8::StaticOrder S; S.init(M_ALL, NZ, F.G, (int)blockIdx.x);
        epi::EpiZ E{WSP(float, WS_ZF), WSP(bf16_t, WS_GB), WSP(bf16_t, WS_U), WSP(bf16_t, WS_GCV), WSP(bf16_t, WS_GML), F.out + O_CONVP, F.out + O_CONVS};
        pg8::gemm_phase<epi::EpiZ, pg8::StaticOrder, true, true>(F.lds + RING_OFF, g, S, E);
        SEAM(1);
    }
    if (IN(2)) { p2_thin(F); SEAM(2); }
    if (IN(3)) {
#ifndef P3S
#define P3S 7
#endif
        if (P3S & 1) { pg8::Gemm g{WSP(bf16_t, WS_CQN), WSP(bf16_t, WS_WUQ), M_ALL, 768, QLORA}; pg8::StaticOrder S; S.init(M_ALL, 768, F.G, (int)blockIdx.x);
          epi::EpiQ E{WSP(bf16_t, WS_Q), WSP(float, WS_TAB)};
          pg8::gemm_phase<epi::EpiQ, pg8::StaticOrder, true, true>(F.lds + RING_OFF, g, S, E); }
        if (P3S & 2) { pg8::Gemm g{WSP(bf16_t, WS_CKV), WSP(bf16_t, WS_WKV), M_ALL, 1024, KVL}; pg8::StaticOrder S; S.init(M_ALL, 1024, F.G, (int)blockIdx.x);
          epi::EpiBf16S<1024> E{WSP(bf16_t, WS_KV), 1.0f};
          pg8::gemm_phase<epi::EpiBf16S<1024>, pg8::StaticOrder, true, true>(F.lds + RING_OFF, g, S, E); }
        if (P3S & 4) { pg8::Gemm g{WSP(bf16_t, WS_CQN) + (size_t)ROW_S * QLORA, WSP(bf16_t, WS_WABS), M_S, 2048, QLORA}; pg8::StaticOrder S; S.init(M_S, 2048, F.G, (int)blockIdx.x);
          epi::EpiBf16S<2048> E{WSP(bf16_t, WS_QLAT), QSCALE};
          pg8::gemm_phase<epi::EpiBf16S<2048>, pg8::StaticOrder, true, true>(F.lds + RING_OFF, g, S, E); }
        SEAM(3);
    }
    if (IN(4)) { attn_prompt_naive(F); attn_decode_naive(F); SEAM(4); }
    if (IN(5)) { decode_combine(F); SEAM(5); }
    if (IN(6)) {
        pg8::Gemm g{WSP(bf16_t, WS_CV), WSP(bf16_t, WS_WCO), M_ALL, D, CDIM}; pg8::StaticOrder S; S.init(M_ALL, D, F.G, (int)blockIdx.x);
        epi::EpiGateT E{WSP(bf16_t, WS_GCV), WSP(float, WS_T)};
        pg8::gemm_phase<epi::EpiGateT, pg8::StaticOrder, true, true>(F.lds + RING_OFF, g, S, E);
        SEAM(6);
    }
    if (IN(7)) {
        pg8::Gemm g{WSP(bf16_t, WS_O), WSP(bf16_t, WS_WOM), M_ALL, D, 512}; pg8::StaticOrder S; S.init(M_ALL, D, F.G, (int)blockIdx.x);
        epi::EpiMix E{WSP(bf16_t, WS_GML), WSP(float, WS_T), WSP(bf16_t, WS_MIXIN)};
        pg8::gemm_phase<epi::EpiMix, pg8::StaticOrder, true, true>(F.lds + RING_OFF, g, S, E);
        SEAM(7);
    }
    if (IN(8)) {
        pg8::Gemm g{WSP(bf16_t, WS_MIXIN), WSP(bf16_t, WS_WO), M_ALL, D, D}; pg8::StaticOrder S; S.init(M_ALL, D, F.G, (int)blockIdx.x);
        epi::EpiRes E{WSP(float, WS_H32), WSP(float, WS_R1)};
        pg8::gemm_phase<epi::EpiRes, pg8::StaticOrder, true, true>(F.lds + RING_OFF, g, S, E);
        SEAM(8);
    }
    if (IN(9)) { ln_pass(F, WSP(float, WS_R1), F.ln1_g, F.ln1_b, WSP(float, WS_H1), WSP(bf16, WS_H1N), ROW_M); SEAM(9); }
    if (IN(10)) {
        pg8::Gemm g{WSP(bf16_t, WS_H1N), WSP(bf16_t, WS_WUP), M_ALL, FF, D}; pg8::StaticOrder S; S.init(M_ALL, FF, F.G, (int)blockIdx.x);
        epi::EpiRelu2 E{WSP(bf16_t, WS_UP)};
        pg8::gemm_phase<epi::EpiRelu2, pg8::StaticOrder, true, true>(F.lds + RING_OFF, g, S, E);
        SEAM(10);
    }
    if (IN(11)) {
        pg8::Gemm g{WSP(bf16_t, WS_UP), WSP(bf16_t, WS_WDN), M_ALL, D, FF}; pg8::StaticOrder S; S.init(M_ALL, D, F.G, (int)blockIdx.x);
        epi::EpiRes E{WSP(float, WS_H1), WSP(float, WS_R2)};
        pg8::gemm_phase<epi::EpiRes, pg8::StaticOrder, true, true>(F.lds + RING_OFF, g, S, E);
        SEAM(11);
    }
    if (IN(12)) { ln_pass(F, WSP(float, WS_R2), F.ln2_g, F.ln2_b, F.out + O_YP, nullptr, ROW_M); }
#ifdef DBG_OFF
    {
        if (hi < NPHASE) xcd_barrier(bar);
        const bf16* B = WSP(bf16, DBG_OFF); const int gw = F.vcu * NWAVES + F.wave, NGW = F.G * NWAVES;
        for (int m = gw; m < ROW_M; m += NGW) for (int c = F.lane; c < D; c += 64) F.out[(size_t)m * D + c] = c < DBG_LD ? (DBG_C0 < 0 ? ((const float*)B)[(size_t)m * DBG_LD + c] : bf2f(B[(size_t)m * DBG_LD + c + (DBG_C0 < 0 ? 0 : DBG_C0)])) : 0.f;
    }
#endif
#undef IN
#undef SEAM
}

extern "C" void kernel_launch(void* const* d_in, const int* in_sizes, int n_in, void* d_out, int out_size, void* d_ws, size_t ws_size, hipStream_t stream) {
    static int grid = 0;
    if (grid == 0) {
        if (n_in != 25 || (size_t)out_size != O_END || ws_size < WS_END) { fprintf(stderr, "kernel_launch: unexpected shapes: n_in %d out %d ws %zu (need %zu)\n", n_in, out_size, ws_size, (size_t)WS_END); grid = -1; return; }
        int dev = 0, cus = 0, per_cu = 0;
        if (hipGetDevice(&dev) != hipSuccess || hipDeviceGetAttribute(&cus, hipDeviceAttributeMultiprocessorCount, dev) != hipSuccess) { grid = -1; return; }
        if (hipFuncSetAttribute((const void*)fwd_kernel, hipFuncAttributeMaxDynamicSharedMemorySize, LDS_BYTES) != hipSuccess) { fprintf(stderr, "kernel_launch: hipFuncSetAttribute failed\n"); grid = -1; return; }
        if (hipOccupancyMaxActiveBlocksPerMultiprocessor(&per_cu, (const void*)fwd_kernel, NWAVES * 64, LDS_BYTES) != hipSuccess || per_cu < 1)
            fprintf(stderr, "kernel_launch: note: occupancy query reports %d workgroups per CU\n", per_cu);
        (void)hipGetLastError();
        grid = cus;
    }
    if (grid < 0) return;
    if (hipMemsetAsync((char*)d_ws + WS_CTL, 0, CTL_ZERO_BYTES, stream) != hipSuccess) return;
    Args a{};
    for (int i = 0; i < 25; ++i) a.in[i] = d_in[i];
    a.out = (float*)d_out; a.ws = (unsigned char*)d_ws;
#if MK_N_LAUNCHES == 1
#ifndef PH_HI
#define PH_HI NPHASE
#endif
    a.ph_lo = 0; a.ph_hi = PH_HI;
    hipLaunchKernelGGL(fwd_kernel, dim3(grid), dim3(NWAVES * 64), LDS_BYTES, stream, a);
#else
    for (int p = 0; p < NPHASE; ++p) { a.ph_lo = p; a.ph_hi = p + 1; hipLaunchKernelGGL(fwd_kernel, dim3(grid), dim3(NWAVES * 64), LDS_BYTES, stream, a); }
#endif
}
```

```cpp
#include <hip/hip_runtime.h>
#include <cstdio>
#include <cstdint>
#include <cmath>
#define MK_N_LAUNCHES 1
constexpr int D = 1024, NB = 16, SEQ = 2048, NMETA = 16, LP = SEQ + NMETA;
constexpr int DBATCH = 128, DSEQ = 8, PAST = 8192, PAGE = 128, NPG = PAST / PAGE;
constexpr int NH = 8, QLORA = 384, KVL = 256, NOPE = 64, ROPE = 32, QHD = NOPE + ROPE, VHD = 64;
constexpr int CDIM = 512, FF = 4096, DIN = 4256;
constexpr int M_P = NB * SEQ;
constexpr int M_S = DBATCH * DSEQ;
constexpr int ROW_S = M_P, ROW_M = M_P + M_S;
constexpr int M_ALL = ROW_M + 256;
constexpr int NZ = 4352;
constexpr int NTAB = LP + DSEQ;
constexpr float LN_EPS = 1e-5f, RMS_EPS = 1e-6f;
constexpr float ALPHA = 1.189207115002721f;
constexpr float QSCALE = 0.10206207261596577f * 1.4426950408889634f;
constexpr int NSPLIT = 4;

constexpr int ZC_CQ = 0, ZC_CKV = 384, ZC_KPE = 640, ZC_GB = 672, ZC_GC = 1184, ZC_CH = 1696, ZC_GCV = 2208, ZC_GML = 3232;

constexpr size_t O_YP = 0, O_YS = O_YP + (size_t)M_P * D, O_CKVP = O_YS + (size_t)M_S * D, O_KPEP = O_CKVP + (size_t)NB * LP * KVL,
                 O_CONVP = O_KPEP + (size_t)NB * LP * ROPE, O_CKVS = O_CONVP + (size_t)NB * 2 * CDIM, O_KPES = O_CKVS + (size_t)M_S * KVL,
                 O_CONVS = O_KPES + (size_t)M_S * ROPE, O_END = O_CONVS + (size_t)DBATCH * 2 * CDIM;

constexpr size_t MiB = 1u << 20;
constexpr size_t al(size_t x) { return (x + MiB - 1) / MiB * MiB; }
constexpr size_t WS_CTL = 0, CTL_ZERO_BYTES = 1 * MiB;
constexpr size_t WS_WIN = 1 * MiB;
constexpr size_t WS_WUQ = WS_WIN + al((size_t)NZ * D * 2);
constexpr size_t WS_WABS = WS_WUQ + al((size_t)768 * QLORA * 2);
constexpr size_t WS_WKV = WS_WABS + al((size_t)2048 * QLORA * 2);
constexpr size_t WS_WCO = WS_WKV + al((size_t)1024 * KVL * 2);
constexpr size_t WS_WOM = WS_WCO + al((size_t)D * CDIM * 2);
constexpr size_t WS_WO = WS_WOM + al((size_t)D * 512 * 2);
constexpr size_t WS_WUP = WS_WO + al((size_t)D * D * 2);
constexpr size_t WS_WDN = WS_WUP + al((size_t)FF * D * 2);
constexpr size_t WS_TAB = WS_WDN + al((size_t)D * FF * 2);
constexpr size_t WS_XN = WS_TAB + al((size_t)NTAB * 32 * 4);
constexpr size_t WS_H32 = WS_XN + al((size_t)M_ALL * D * 2);
constexpr size_t WS_ZF = WS_H32 + al((size_t)M_ALL * D * 4);
constexpr size_t WS_GB = WS_ZF + al((size_t)M_ALL * 768 * 4);
constexpr size_t WS_U = WS_GB + al((size_t)M_ALL * 512 * 2);
constexpr size_t WS_GCV = WS_U + al((size_t)M_ALL * 512 * 2);
constexpr size_t WS_GML = WS_GCV + al((size_t)M_ALL * D * 2);
constexpr size_t WS_CQN = WS_GML + al((size_t)M_ALL * D * 2);
constexpr size_t WS_CKV = WS_CQN + al((size_t)M_ALL * QLORA * 2);
constexpr size_t WS_KPE = WS_CKV + al((size_t)M_ALL * KVL * 2);
constexpr size_t WS_CV = WS_KPE + al((size_t)M_ALL * ROPE * 2);
constexpr size_t WS_Q = WS_CV + al((size_t)M_ALL * CDIM * 2);
constexpr size_t WS_KV = WS_Q + al((size_t)M_ALL * 768 * 2);
constexpr size_t WS_QLAT = WS_KV + al((size_t)M_ALL * 1024 * 2);
constexpr size_t WS_O = WS_QLAT + al((size_t)M_S * 2048 * 2);
constexpr size_t WS_PART = WS_O + al((size_t)M_ALL * 512 * 2);
constexpr size_t WS_T = WS_PART + al((size_t)DBATCH * NSPLIT * 64 * 264 * 4);
constexpr size_t WS_MIXIN = WS_T + al((size_t)M_ALL * D * 4);
constexpr size_t WS_R1 = WS_MIXIN + al((size_t)M_ALL * D * 2);
constexpr size_t WS_H1 = WS_R1 + al((size_t)M_ALL * D * 4);
constexpr size_t WS_H1N = WS_H1 + al((size_t)M_ALL * D * 4);
constexpr size_t WS_UP = WS_H1N + al((size_t)M_ALL * D * 2);
constexpr size_t WS_R2 = WS_UP + al((size_t)M_ALL * FF * 2);
constexpr size_t WS_END = WS_R2 + al((size_t)M_ALL * D * 4);
constexpr int CW_TMO = 0, CW_CODE = 1, CW_BAR = 4096;

constexpr int RING_OFF = 0, RING_BYTES = 131072;
constexpr int LDSCTL_OFF = RING_BYTES, MISC_OFF = LDSCTL_OFF + 320;
constexpr int LDS_BYTES = 147456;
constexpr int NWAVES = 8;
namespace pg8 {
#define PG8_LAS __attribute__((address_space(3)))
typedef unsigned short bf16_t;
typedef short bf16x8 __attribute__((ext_vector_type(8)));
typedef float f32x4 __attribute__((ext_vector_type(4)));
typedef unsigned u32x4 __attribute__((ext_vector_type(4)));
constexpr int BM = 256, BK = 64, HALF = 128, HTB = HALF * BK * 2  , STAGE_BYTES = 8 * HTB, NXCD = 8, WGM = 8;

__host__ __device__ __forceinline__ int lds_byte(int r, int c) { const int st = (r >> 4) * 2 + (c >> 5), rr = r & 15, cc = c & 31, ob = rr * 64 + cc * 2; return st * 1024 + (ob ^ (((ob >> 9) & 1) << 5)); }
__host__ __device__ __forceinline__ void stage_rc(int b, int& R, int& C) { const int st = b / 1024, sb = b % 1024, swz = sb ^ (((sb >> 9) & 1) << 5); R = (st >> 1) * 16 + swz / 64; C = (st & 1) * 32 + (swz % 64) / 2; }
__host__ __device__ __forceinline__ int perm32(int rho) { const int n = rho >> 4, i = rho & 15; return 8 * (i >> 2) + 4 * n + (i & 3); }

struct Unit { int pm, pn; };
struct Gemm { const bf16_t* A; const bf16_t* Bt; int M, N, K; };

struct StaticOrder {
    int nM, nN, nwg, G, c;
    __host__ __device__ void init(int M, int N, int G_, int c_) { nM = M / BM; nN = N / BM; nwg = nM * nN; G = G_; c = c_; }
    __host__ __device__ bool next(int i, Unit& u) const {
        const long L = (long)i * G + c; if (L >= nwg) return false;
        int wgid = (int)L; { const int q = nwg / NXCD, r = nwg % NXCD, xcd = wgid % NXCD, off = wgid / NXCD; wgid = (xcd < r ? xcd * (q + 1) : r * (q + 1) + (xcd - r) * q) + off; }
        const int nig = WGM * nN, gid = wgid / nig, fm = gid * WGM, gsz = (nM - fm) < WGM ? (nM - fm) : WGM;
        u.pm = fm + ((wgid % nig) % gsz); u.pn = (wgid % nig) / gsz; return true;
    }
    __device__ __forceinline__ void a_ready(const Unit&) const {}
    __device__ __forceinline__ void done(const Unit&) const {}
};

__device__ __forceinline__ unsigned cvt_pk_bf16(float lo, float hi) { unsigned r; asm volatile("v_cvt_pk_bf16_f32 %0, %1, %2" : "=v"(r) : "v"(lo), "v"(hi)); return r; }
typedef float f32x2 __attribute__((ext_vector_type(2)));
template <class Epi, class Sched, bool ALIGN_EPI = false, bool SP2 = false>
__device__ __forceinline__ void gemm_phase(PG8_LAS unsigned char* lds, const Gemm g, const Sched& S, const Epi& E) {
    const int tid = threadIdx.x, wid = __builtin_amdgcn_readfirstlane(tid >> 6), lane = tid & 63, wr = wid >> 2, wc = wid & 3, fr = lane & 15, fq = lane >> 4;
    const int K = g.K, nt = K / BK;
    unsigned voffA[2], voffB[2];
#pragma unroll
    for (int i = 0; i < 2; ++i) { int R, C; stage_rc(tid * 16 + i * 8192, R, C); const int Rb = Epi::PERM ? ((R & ~31) + perm32(R & 31)) : R;
        voffA[i] = (unsigned)(R * K + C) * 2u; voffB[i] = (unsigned)(Rb * K + C) * 2u; }
    const size_t kstep = (size_t)(BK * 2);
    const size_t hstep = (size_t)HALF * K * 2;
    const size_t tstep = 2 * hstep;
    const unsigned ldsw = (unsigned)wid * 1024u;
    const int aoff = lds_byte(wr * 64 + fr, fq * 8), boff = lds_byte(wc * 32 + fr, fq * 8);
#define PG8_SA(b, h) (((b) * 2 + (h)) * HTB)
#define PG8_SB(b, h) ((4 + (b) * 2 + (h)) * HTB)
#define PG8_STAGE(bufoff, gbase, voff) do { _Pragma("unroll") for (int _i = 0; _i < 2; ++_i) \
        __builtin_amdgcn_global_load_lds((const unsigned*)((const char*)(gbase) + (voff)[_i]), (PG8_LAS unsigned*)(lds + (bufoff) + ldsw + _i * 8192), 16, 0, 0); } while (0)
#define PG8_LDA(dst, b, h) do { _Pragma("unroll") for (int m = 0; m < 4; ++m) _Pragma("unroll") for (int k = 0; k < 2; ++k) dst[m][k] = *(const PG8_LAS bf16x8*)(lds + PG8_SA(b, h) + aoff + m * 2048 + k * 1024); } while (0)
#define PG8_LDB(dst, b, h) do { _Pragma("unroll") for (int n = 0; n < 2; ++n) _Pragma("unroll") for (int k = 0; k < 2; ++k) dst[n][k] = *(const PG8_LAS bf16x8*)(lds + PG8_SB(b, h) + boff + n * 2048 + k * 1024); } while (0)
#define PG8_MMA(ai, bj, At, Bt) do { __builtin_amdgcn_s_setprio(1); _Pragma("unroll") for (int m = 0; m < 4; ++m) _Pragma("unroll") for (int n = 0; n < 2; ++n) _Pragma("unroll") for (int k = 0; k < 2; ++k) \
        acc[ai][bj][m][n] = __builtin_amdgcn_mfma_f32_16x16x32_bf16(Bt[n][k], At[m][k], acc[ai][bj][m][n], 0, 0, 0); __builtin_amdgcn_s_setprio(0); } while (0)
#define PG8_WAIT_V(n) asm volatile("s_waitcnt vmcnt(" #n ")" ::: "memory")
#define PG8_WAIT_L(n) asm volatile("s_waitcnt lgkmcnt(" #n ")" ::: "memory")
#define PG8_BAR __builtin_amdgcn_s_barrier()
#define PG8_SCHED __builtin_amdgcn_sched_barrier(0)
    Unit cur, nxt; int ui = 0;
    if (!S.next(0, cur)) return;
    f32x4 acc[2][2][4][2];
#pragma unroll
    for (int a = 0; a < 2; ++a)
#pragma unroll
        for (int b = 0; b < 2; ++b)
#pragma unroll
            for (int m = 0; m < 4; ++m)
#pragma unroll
                for (int n = 0; n < 2; ++n) acc[a][b][m][n] = (f32x4){0.f, 0.f, 0.f, 0.f};
    bf16x8 At[4][2], B0[2][2], B1[2][2];
    const char* cA = (const char*)g.A + (size_t)cur.pm * tstep; const char* cB = (const char*)g.Bt + (size_t)cur.pn * tstep;
    S.a_ready(cur);
    if constexpr (SP2) {
        PG8_STAGE(PG8_SB(0, 0), cB, voffB); PG8_STAGE(PG8_SB(0, 1), cB + hstep, voffB); PG8_STAGE(PG8_SA(0, 0), cA, voffA); PG8_STAGE(PG8_SA(0, 1), cA + hstep, voffA);
        if (wr == 1) PG8_BAR;
        PG8_WAIT_V(2); PG8_BAR;
        PG8_STAGE(PG8_SB(1, 0), cB + kstep, voffB); PG8_STAGE(PG8_SA(1, 0), cA + kstep, voffA); PG8_STAGE(PG8_SB(1, 1), cB + hstep + kstep, voffB);
        PG8_WAIT_V(6); PG8_BAR;
    } else {
        PG8_STAGE(PG8_SB(0, 0), cB, voffB); PG8_STAGE(PG8_SA(0, 0), cA, voffA); PG8_STAGE(PG8_SB(0, 1), cB + hstep, voffB); PG8_STAGE(PG8_SA(0, 1), cA + hstep, voffA);
        if (wr == 1) PG8_BAR;
        PG8_WAIT_V(4); PG8_BAR;
        PG8_STAGE(PG8_SB(1, 0), cB + kstep, voffB); PG8_STAGE(PG8_SA(1, 0), cA + kstep, voffA); PG8_STAGE(PG8_SB(1, 1), cB + hstep + kstep, voffB);
        PG8_WAIT_V(6); PG8_BAR;
    }
    for (;;) {
        const bool has_next = S.next(ui + 1, nxt);
        const char* nA = has_next ? (const char*)g.A + (size_t)nxt.pm * tstep : cA; const char* nB = has_next ? (const char*)g.Bt + (size_t)nxt.pn * tstep : cB;
#pragma unroll 1
        for (int t = 0; t < nt; t += 2) {
            const bool last = (t == nt - 2);
            const char* a1 = cA + (size_t)(t + 1) * kstep;
            const char* a2 = last ? nA : cA + (size_t)(t + 2) * kstep; const char* b2 = last ? nB : cB + (size_t)(t + 2) * kstep;
            const char* a3 = a2 + kstep; const char* b3 = b2 + kstep;
            if (last && has_next) S.a_ready(nxt);
            if constexpr (SP2) {
            PG8_LDB(B0, 0, 0); PG8_LDB(B1, 0, 1); PG8_SCHED; PG8_LDA(At, 0, 0); PG8_STAGE(PG8_SA(1, 1), a1 + hstep, voffA);
            PG8_WAIT_V(8); PG8_WAIT_L(0); PG8_BAR; PG8_MMA(0, 0, At, B0); PG8_MMA(0, 1, At, B1); PG8_BAR; PG8_SCHED;
            PG8_LDA(At, 0, 1); PG8_STAGE(PG8_SB(0, 0), b2, voffB); PG8_STAGE(PG8_SB(0, 1), b2 + hstep, voffB); PG8_STAGE(PG8_SA(0, 0), a2, voffA);
            PG8_WAIT_V(8); PG8_WAIT_L(0); PG8_BAR; PG8_MMA(1, 0, At, B0); PG8_MMA(1, 1, At, B1); PG8_BAR; PG8_SCHED;
            PG8_LDB(B0, 1, 0); PG8_LDB(B1, 1, 1); PG8_SCHED; PG8_LDA(At, 1, 0); PG8_STAGE(PG8_SA(0, 1), a2 + hstep, voffA);
            PG8_WAIT_V(8); PG8_WAIT_L(0); PG8_BAR; PG8_MMA(0, 0, At, B0); PG8_MMA(0, 1, At, B1); PG8_BAR; PG8_SCHED;
            PG8_LDA(At, 1, 1); PG8_STAGE(PG8_SB(1, 0), b3, voffB); PG8_STAGE(PG8_SB(1, 1), b3 + hstep, voffB); PG8_STAGE(PG8_SA(1, 0), a3, voffA);
            PG8_WAIT_V(8); PG8_WAIT_L(0); PG8_BAR; PG8_MMA(1, 0, At, B0); PG8_MMA(1, 1, At, B1); PG8_BAR; PG8_SCHED;
            } else {
            PG8_LDB(B0, 0, 0); PG8_SCHED; PG8_LDA(At, 0, 0); PG8_STAGE(PG8_SA(1, 1), a1 + hstep, voffA);
            PG8_WAIT_L(8); PG8_BAR; PG8_WAIT_L(0); PG8_MMA(0, 0, At, B0); PG8_BAR; PG8_SCHED;
            PG8_LDB(B1, 0, 1); PG8_STAGE(PG8_SB(0, 0), b2, voffB);
            PG8_BAR; PG8_WAIT_L(0); PG8_MMA(0, 1, At, B1); PG8_BAR;
            PG8_LDA(At, 0, 1); PG8_STAGE(PG8_SA(0, 0), a2, voffA);
            PG8_BAR; PG8_WAIT_L(0); PG8_MMA(1, 0, At, B0); PG8_BAR; PG8_SCHED;
            PG8_STAGE(PG8_SB(0, 1), b2 + hstep, voffB);
            PG8_WAIT_V(6); PG8_BAR; PG8_MMA(1, 1, At, B1); PG8_BAR;
            PG8_LDB(B0, 1, 0); PG8_SCHED; PG8_LDA(At, 1, 0); PG8_STAGE(PG8_SA(0, 1), a2 + hstep, voffA);
            PG8_WAIT_L(8); PG8_BAR; PG8_WAIT_L(0); PG8_MMA(0, 0, At, B0); PG8_BAR; PG8_SCHED;
            PG8_LDB(B1, 1, 1); PG8_STAGE(PG8_SB(1, 0), b3, voffB);
            PG8_BAR; PG8_WAIT_L(0); PG8_MMA(0, 1, At, B1); PG8_BAR;
            PG8_LDA(At, 1, 1); PG8_STAGE(PG8_SA(1, 0), a3, voffA);
            PG8_BAR; PG8_WAIT_L(0); PG8_MMA(1, 0, At, B0); PG8_BAR; PG8_SCHED;
            PG8_STAGE(PG8_SB(1, 1), b3 + hstep, voffB);
            PG8_WAIT_V(6); PG8_BAR; PG8_MMA(1, 1, At, B1); PG8_BAR;
            }
        }
        if constexpr (ALIGN_EPI) { if (wr == 0) PG8_BAR; }
        if constexpr (!Epi::AFTER_DRAIN) { E(acc, cur, wr, wc, fr, fq); S.done(cur); }
        if (!has_next) break;
#pragma unroll
        for (int a = 0; a < 2; ++a)
#pragma unroll
            for (int b = 0; b < 2; ++b)
#pragma unroll
                for (int m = 0; m < 4; ++m)
#pragma unroll
                    for (int n = 0; n < 2; ++n) acc[a][b][m][n] = (f32x4){0.f, 0.f, 0.f, 0.f};
        cur = nxt; cA = nA; cB = nB; ++ui;
        if constexpr (ALIGN_EPI) { if (wr == 1) PG8_BAR; }
    }
    PG8_WAIT_V(0);
    if constexpr (!ALIGN_EPI) { if (wr == 0) PG8_BAR; }
    PG8_BAR;
    if constexpr (Epi::AFTER_DRAIN) { E.fused(acc, cur, wr, wc, fr, fq, lds, wid, lane); S.done(cur); }
#undef PG8_SA
#undef PG8_SB
#undef PG8_STAGE
#undef PG8_LDA
#undef PG8_LDB
#undef PG8_MMA
#undef PG8_WAIT_V
#undef PG8_WAIT_L
#undef PG8_BAR
#undef PG8_SCHED
}
}
#define GAS __attribute__((address_space(1)))
#define LAS __attribute__((address_space(3)))
typedef unsigned short bf16;
typedef unsigned v4u __attribute__((ext_vector_type(4)));
typedef float f32x4 __attribute__((ext_vector_type(4)));
typedef short bf16x8 __attribute__((ext_vector_type(8)));
typedef GAS unsigned gu32;
typedef GAS unsigned long long gu64;
#define RLX_AGENT __ATOMIC_RELAXED, __HIP_MEMORY_SCOPE_AGENT
#define LDS_WAIT() asm volatile("s_waitcnt lgkmcnt(0)" ::: "memory")
#define VM_WAIT() asm volatile("s_waitcnt vmcnt(0)" ::: "memory")
__device__ __forceinline__ unsigned long long rt() { return __builtin_amdgcn_s_memrealtime(); }
__device__ __forceinline__ unsigned f2bf(float f) { unsigned u = __builtin_bit_cast(unsigned, f); return (u + 0x7fffu + ((u >> 16) & 1u)) >> 16; }
__device__ __forceinline__ unsigned pk2(float lo, float hi) { return f2bf(lo) | (f2bf(hi) << 16); }

#define XB_TMO      128
#define XB_XCNT(j)  (256  + 64 * (j))
#define XB_XSUB(j)  (1280 + 64 * (j))
#define XB_XGEN(j)  (2304 + 64 * (j))
#define XB_TOP      3328
#define XB_TOPGEN   3392
#define XCD_BAR_WORDS 3456
#define XB_SPIN_CAP (1u << 18)

__device__ __forceinline__ unsigned xb_ld(unsigned* p)              { return __hip_atomic_load(p, __ATOMIC_RELAXED, __HIP_MEMORY_SCOPE_AGENT); }
__device__ __forceinline__ unsigned xb_add(unsigned* p, unsigned v) { return __hip_atomic_fetch_add(p, v, __ATOMIC_RELAXED, __HIP_MEMORY_SCOPE_AGENT); }
__device__ __forceinline__ unsigned xb_xcc_id() { return (unsigned)__builtin_amdgcn_s_getreg((3 << 11) | 20) & 0xFu; }
#define XB_SPIN(cond, bar) do { unsigned _sp = 0; while (cond) { __builtin_amdgcn_s_sleep(1); \
    if ((++_sp & 255u) == 0u) { if (xb_ld(&(bar)[XB_TMO])) break; if (_sp > XB_SPIN_CAP) { atomicAdd(&(bar)[XB_TMO], 1u); break; } } } } while (0)

struct XcdBarrier {
    unsigned* bar; unsigned x;
    volatile LAS unsigned* st;
};

__device__ __forceinline__ XcdBarrier xcd_barrier_post(unsigned* bar, volatile LAS unsigned* st) {
    XcdBarrier b; b.bar = bar; b.x = xb_xcc_id(); b.st = st;
    if (threadIdx.x == 0) (void)xb_add(&bar[XB_XCNT(b.x)], 1u);
    return b;
}
__device__ __forceinline__ void xcd_barrier_complete(unsigned* bar, unsigned x, unsigned& nloc, unsigned& nx) {
    const unsigned G = gridDim.x * gridDim.y * gridDim.z;
    unsigned sum, cnt, mine, sp = 0u;
    for (;;) {
        sum = 0u; cnt = 0u; mine = 0u;
#pragma unroll
        for (unsigned j = 0; j < 16; ++j) { const unsigned c = xb_ld(&bar[XB_XCNT(j)]); sum += c; cnt += (c > 0u) ? 1u : 0u; mine = (j == x) ? c : mine; }
        if (sum == G) break;
        __builtin_amdgcn_s_sleep(1);
        if ((++sp & 255u) == 0u) { if (xb_ld(&bar[XB_TMO])) break; if (sp > XB_SPIN_CAP) { atomicAdd(&bar[XB_TMO], 1u); break; } }
    }
    nloc = mine > 0u ? mine : 1u; nx = cnt > 0u ? cnt : 1u;
}

__device__ __forceinline__ void xcd_barrier(const XcdBarrier& b) {
    asm volatile("s_waitcnt vmcnt(0)" ::: "memory");
    __syncthreads();
    if (threadIdx.x == 0) {
        unsigned* bar = b.bar;
        __builtin_amdgcn_s_waitcnt(0);
        unsigned nloc = b.st[0], nx = b.st[1];
        if (nloc == 0u) { xcd_barrier_complete(bar, b.x, nloc, nx); b.st[0] = nloc; b.st[1] = nx; }
        const unsigned old = xb_add(&bar[XB_XSUB(b.x)], 1u);
        const unsigned gen = old / nloc;
        if (old + 1u == (gen + 1u) * nloc) {
            __builtin_amdgcn_fence(__ATOMIC_RELEASE, "agent");
            asm volatile("s_waitcnt vmcnt(0)" ::: "memory");
            const unsigned og = xb_add(&bar[XB_TOP], 1u);
            const unsigned tg = og / nx;
            if (og + 1u == (tg + 1u) * nx) xb_add(&bar[XB_TOPGEN], 1u);
            else XB_SPIN(xb_ld(&bar[XB_TOPGEN]) == tg, bar);
            __builtin_amdgcn_fence(__ATOMIC_ACQUIRE, "agent");
            xb_add(&bar[XB_XGEN(b.x)], 1u);
            asm volatile("s_waitcnt vmcnt(0)" ::: "memory");
        } else {
            XB_SPIN(xb_ld(&bar[XB_XGEN(b.x)]) == gen, bar);
            __builtin_amdgcn_fence(__ATOMIC_ACQUIRE, "agent");
            asm volatile("s_waitcnt vmcnt(0)" ::: "memory");
        }
    }
    __syncthreads();
}
namespace epi {
using pg8::f32x4; using pg8::u32x4; using pg8::bf16_t; using pg8::Unit;
typedef float f32x2_t __attribute__((ext_vector_type(2))); typedef __bf16 bf16x2_t __attribute__((ext_vector_type(2)));
__device__ __forceinline__ unsigned cvt_pk_bf16(float lo, float hi) { f32x2_t v = {lo, hi}; bf16x2_t b = __builtin_convertvector(v, bf16x2_t); return __builtin_bit_cast(unsigned, b); }
typedef unsigned u32x2 __attribute__((ext_vector_type(2)));
typedef const f32x4 (&Acc)[2][2][4][2];
__device__ __forceinline__ u32x4 pack8(f32x4 a, f32x4 b) { u32x4 w; w.x = cvt_pk_bf16(a[0], a[1]); w.y = cvt_pk_bf16(a[2], a[3]); w.z = cvt_pk_bf16(b[0], b[1]); w.w = cvt_pk_bf16(b[2], b[3]); return w; }
__device__ __forceinline__ f32x4 unpack_lo(unsigned a, unsigned b) { return (f32x4){__uint_as_float(a << 16), __uint_as_float(a & 0xffff0000u), __uint_as_float(b << 16), __uint_as_float(b & 0xffff0000u)}; }
__device__ __forceinline__ float sigmoidf_(float x) { return __builtin_amdgcn_rcpf(1.0f + __builtin_amdgcn_exp2f(-1.4426950408889634f * x)); }
__device__ __forceinline__ f32x4 sig4(f32x4 v) { return (f32x4){sigmoidf_(v[0]), sigmoidf_(v[1]), sigmoidf_(v[2]), sigmoidf_(v[3])}; }
__device__ __forceinline__ int tab_pos(int row) { return row < M_P ? NMETA + (row & (SEQ - 1)) : (row < ROW_M ? LP + ((row - ROW_S) & (DSEQ - 1)) : (row - ROW_M < NMETA ? row - ROW_M : NMETA - 1)); }

struct EpiZ {
    static constexpr bool PERM = true, AFTER_DRAIN = false;
    float* ZF; bf16_t* GB; bf16_t* U; bf16_t* GCV; bf16_t* GML; float* conv_p; float* conv_s;
    __device__ __forceinline__ void operator()(Acc acc, const Unit& u, int wr, int wc, int fr, int fq) const {
        const int pn = u.pn, row0 = u.pm * 256 + wr * 64 + fr, cl = wc * 32 + 8 * fq;
        if (pn < 3) {
#pragma unroll
            for (int ai = 0; ai < 2; ++ai)
#pragma unroll
                for (int m = 0; m < 4; ++m) { float* rp = ZF + (size_t)(row0 + ai * 128 + m * 16) * 768 + pn * 256 + cl;
#pragma unroll
                    for (int bj = 0; bj < 2; ++bj) { *(f32x4*)(rp + bj * 128) = acc[ai][bj][m][0]; *(f32x4*)(rp + bj * 128 + 4) = acc[ai][bj][m][1]; } }
        } else if (pn < 5) {
#pragma unroll
            for (int ai = 0; ai < 2; ++ai)
#pragma unroll
                for (int m = 0; m < 4; ++m) { bf16_t* rp = GB + (size_t)(row0 + ai * 128 + m * 16) * CDIM + (pn - 3) * 256 + cl;
#pragma unroll
                    for (int bj = 0; bj < 2; ++bj) *(u32x4*)(rp + bj * 128) = pack8(acc[ai][bj][m][0], acc[ai][bj][m][1]); }
        } else if (pn < 9) {
            const int cu = (pn - 5) * 128 + cl;
#pragma unroll
            for (int ai = 0; ai < 2; ++ai)
#pragma unroll
                for (int m = 0; m < 4; ++m) { const int row = row0 + ai * 128 + m * 16;
                    const f32x4 u0 = acc[ai][0][m][0] * acc[ai][1][m][0], u1 = acc[ai][0][m][1] * acc[ai][1][m][1];
                    *(u32x4*)(U + (size_t)row * CDIM + cu) = pack8(u0, u1);
                    if (row < M_P) { const int t = row & (SEQ - 1); if (t >= SEQ - 2) { float* o = conv_p + ((size_t)(row >> 11) * 2 + (t - (SEQ - 2))) * CDIM + cu; *(f32x4*)o = u0; *(f32x4*)(o + 4) = u1; } }
                    else if (row < ROW_M) { const int j = (row - ROW_S) & 7; if (j >= 6) { float* o = conv_s + ((size_t)((row - ROW_S) >> 3) * 2 + (j - 6)) * CDIM + cu; *(f32x4*)o = u0; *(f32x4*)(o + 4) = u1; } } }
        } else {
            bf16_t* base = (pn < 13 ? GCV + (pn - 9) * 256 : GML + (pn - 13) * 256) + cl;
#pragma unroll
            for (int ai = 0; ai < 2; ++ai)
#pragma unroll
                for (int m = 0; m < 4; ++m) { bf16_t* rp = base + (size_t)(row0 + ai * 128 + m * 16) * D;
#pragma unroll
                    for (int bj = 0; bj < 2; ++bj) *(u32x4*)(rp + bj * 128) = pack8(sig4(acc[ai][bj][m][0]), sig4(acc[ai][bj][m][1])); }
        }
    }
};
struct EpiQ {
    static constexpr bool PERM = false, AFTER_DRAIN = false;
    bf16_t* Q; const float* tab;
    __device__ __forceinline__ void operator()(Acc acc, const Unit& u, int wr, int wc, int fr, int fq) const {
        const int row0 = u.pm * 256 + wr * 64 + fr;
        const int G0 = u.pn * 8 + wc, G1 = G0 + 4; const bool pe0 = (G0 % 3) == 2, pe1 = (G1 % 3) == 2;
#pragma unroll
        for (int ai = 0; ai < 2; ++ai)
#pragma unroll
            for (int m = 0; m < 4; ++m) { const int row = row0 + ai * 128 + m * 16; bf16_t* rp = Q + (size_t)row * 768 + 4 * fq;
                f32x4 cs = (f32x4){1.f, 1.f, 1.f, 1.f}, sn = (f32x4){0.f, 0.f, 0.f, 0.f};
                if (pe0 || pe1) { const float* tp = tab + (size_t)tab_pos(row) * 32 + 4 * fq; cs = *(const f32x4*)tp; sn = *(const f32x4*)(tp + 16); }
#pragma unroll
                for (int bj = 0; bj < 2; ++bj) { f32x4 a = acc[ai][bj][m][0], b = acc[ai][bj][m][1];
                    if (bj == 0 ? pe0 : pe1) { const f32x4 y1 = a * cs - b * sn, y2 = b * cs + a * sn; a = y1; b = y2; }
                    a = a * QSCALE; b = b * QSCALE;
                    u32x2 w0, w1; w0.x = cvt_pk_bf16(a[0], a[1]); w0.y = cvt_pk_bf16(a[2], a[3]); w1.x = cvt_pk_bf16(b[0], b[1]); w1.y = cvt_pk_bf16(b[2], b[3]);
                    bf16_t* cp = rp + (bj == 0 ? G0 : G1) * 32; *(u32x2*)cp = w0; *(u32x2*)(cp + 16) = w1; }
                asm volatile("" ::: "memory"); }
    }
};
template <int ldc> struct EpiBf16S {
    static constexpr bool PERM = true, AFTER_DRAIN = false;
    bf16_t* O; float s;
    __device__ __forceinline__ void operator()(Acc acc, const Unit& u, int wr, int wc, int fr, int fq) const {
        const int row0 = u.pm * 256 + wr * 64 + fr, col0 = u.pn * 256 + wc * 32 + 8 * fq;
#pragma unroll
        for (int ai = 0; ai < 2; ++ai)
#pragma unroll
            for (int m = 0; m < 4; ++m) { bf16_t* rp = O + (size_t)(row0 + ai * 128 + m * 16) * ldc + col0;
#pragma unroll
                for (int bj = 0; bj < 2; ++bj) *(u32x4*)(rp + bj * 128) = pack8(acc[ai][bj][m][0] * s, acc[ai][bj][m][1] * s); }
    }
};
struct EpiGateT {
    static constexpr bool PERM = true, AFTER_DRAIN = false;
    const bf16_t* G; float* T;
    __device__ __forceinline__ void operator()(Acc acc, const Unit& u, int wr, int wc, int fr, int fq) const {
        const int row0 = u.pm * 256 + wr * 64 + fr, col0 = u.pn * 256 + wc * 32 + 8 * fq;
#pragma unroll
        for (int ai = 0; ai < 2; ++ai)
#pragma unroll
            for (int m = 0; m < 4; ++m) { const size_t off = (size_t)(row0 + ai * 128 + m * 16) * D + col0;
#pragma unroll
                for (int bj = 0; bj < 2; ++bj) { const u32x4 g = *(const u32x4*)(G + off + bj * 128);
                    *(f32x4*)(T + off + bj * 128) = unpack_lo(g.x, g.y) * acc[ai][bj][m][0]; *(f32x4*)(T + off + bj * 128 + 4) = unpack_lo(g.z, g.w) * acc[ai][bj][m][1]; } }
    }
};
struct EpiMix {
    static constexpr bool PERM = true, AFTER_DRAIN = false;
    const bf16_t* G; const float* T; bf16_t* O;
    __device__ __forceinline__ void operator()(Acc acc, const Unit& u, int wr, int wc, int fr, int fq) const {
        const int row0 = u.pm * 256 + wr * 64 + fr, col0 = u.pn * 256 + wc * 32 + 8 * fq;
#pragma unroll
        for (int ai = 0; ai < 2; ++ai)
#pragma unroll
            for (int m = 0; m < 4; ++m) { const size_t off = (size_t)(row0 + ai * 128 + m * 16) * D + col0;
#pragma unroll
                for (int bj = 0; bj < 2; ++bj) { const u32x4 g = *(const u32x4*)(G + off + bj * 128); const f32x4 t0 = *(const f32x4*)(T + off + bj * 128), t1 = *(const f32x4*)(T + off + bj * 128 + 4);
                    *(u32x4*)(O + off + bj * 128) = pack8(t0 + unpack_lo(g.x, g.y) * acc[ai][bj][m][0], t1 + unpack_lo(g.z, g.w) * acc[ai][bj][m][1]); } }
    }
};
struct EpiRes {
    static constexpr bool PERM = true, AFTER_DRAIN = false;
    const float* res; float* R;
    __device__ __forceinline__ void operator()(Acc acc, const Unit& u, int wr, int wc, int fr, int fq) const {
        const int row0 = u.pm * 256 + wr * 64 + fr, col0 = u.pn * 256 + wc * 32 + 8 * fq;
#pragma unroll
        for (int ai = 0; ai < 2; ++ai)
#pragma unroll
            for (int m = 0; m < 4; ++m) { const size_t off = (size_t)(row0 + ai * 128 + m * 16) * D + col0;
#pragma unroll
                for (int bj = 0; bj < 2; ++bj) { const f32x4 r0 = *(const f32x4*)(res + off + bj * 128), r1 = *(const f32x4*)(res + off + bj * 128 + 4);
                    *(f32x4*)(R + off + bj * 128) = r0 * ALPHA + acc[ai][bj][m][0]; *(f32x4*)(R + off + bj * 128 + 4) = r1 * ALPHA + acc[ai][bj][m][1]; } }
    }
};
struct EpiRelu2 {
    static constexpr bool PERM = true, AFTER_DRAIN = false;
    bf16_t* O;
    __device__ __forceinline__ void operator()(Acc acc, const Unit& u, int wr, int wc, int fr, int fq) const {
        const int row0 = u.pm * 256 + wr * 64 + fr, col0 = u.pn * 256 + wc * 32 + 8 * fq;
#pragma unroll
        for (int ai = 0; ai < 2; ++ai)
#pragma unroll
            for (int m = 0; m < 4; ++m) { bf16_t* rp = O + (size_t)(row0 + ai * 128 + m * 16) * FF + col0;
#pragma unroll
                for (int bj = 0; bj < 2; ++bj) { f32x4 a = acc[ai][bj][m][0], b = acc[ai][bj][m][1];
#pragma unroll
                    for (int i = 0; i < 4; ++i) { a[i] = a[i] > 0.f ? a[i] * a[i] : 0.f; b[i] = b[i] > 0.f ? b[i] * b[i] : 0.f; }
                    *(u32x4*)(rp + bj * 128) = pack8(a, b); } }
    }
};
}
namespace pattn {
typedef short bf16x8 __attribute__((ext_vector_type(8)));
typedef short s16x4 __attribute__((ext_vector_type(4)));
typedef float f32x16 __attribute__((ext_vector_type(16)));
typedef unsigned u32x4 __attribute__((ext_vector_type(4)));
typedef __attribute__((address_space(3))) const char* lds_cptr;
constexpr int KSLOT = 12288, VSLOT = 8192, LDS_K = 0, LDS_V = 2 * KSLOT, LDS_WS = LDS_V + 2 * VSLOT, LDS_OST = LDS_WS + 2048, LDS_END = LDS_OST + 8 * 4096;
__device__ __forceinline__ int crow(int r, int hi) { return (r & 3) + 8 * (r >> 2) + 4 * hi; }
__device__ __forceinline__ void glds16(const void* gsrc, unsigned lds_dst) { unsigned keep;
    asm volatile("s_mov_b32 %0, m0\n\ts_mov_b32 m0, %2\n\ts_nop 0\n\tglobal_load_lds_dwordx4 %1, off\n\ts_mov_b32 m0, %0" : "=&s"(keep) : "v"(gsrc), "s"(lds_dst) : "memory"); }
__device__ __forceinline__ s16x4 vtr(lds_cptr p) { return __builtin_bit_cast(s16x4, __builtin_amdgcn_ds_read_tr16_b64_v4i16((__attribute__((address_space(3))) s16x4*)p)); }
__device__ __forceinline__ unsigned cvtpk(float lo, float hi) { return epi::cvt_pk_bf16(lo, hi); }
__device__ __forceinline__ float swapmax(float m) { auto rr = __builtin_amdgcn_permlane32_swap(__float_as_uint(m), __float_as_uint(m), false, false); return fmaxf(__uint_as_float(rr[0]), __uint_as_float(rr[1])); }
__device__ __forceinline__ float swapsum(float m) { auto rr = __builtin_amdgcn_permlane32_swap(__float_as_uint(m), __float_as_uint(m), false, false); return __uint_as_float(rr[0]) + __uint_as_float(rr[1]); }

__device__ __forceinline__ void prompt_unit(int b, int h, int qb, const bf16* Q, const bf16* KV, const bf16* KPE, bf16* O, LAS unsigned char* shm) {
    const int tid = threadIdx.x, lane = tid & 63, r32 = lane & 31, hi = lane >> 5; const int wid = __builtin_amdgcn_readfirstlane(tid >> 6);
    const long rowbase = (long)b * SEQ; const int q0 = qb * 256, NT = 4 * qb + 4;
    const unsigned lds0 = (unsigned)(uintptr_t)shm;
    LAS float* wsf = (LAS float*)(shm + LDS_WS) + wid * 64;
    const lds_cptr shm3 = (lds_cptr)shm;
    const bf16* Qw = Q + (rowbase + q0 + wid * 32 + r32) * 768 + h * QHD;
    bf16x8 qr[6];
#pragma unroll
    for (int d0 = 0; d0 < 6; ++d0) qr[d0] = *(const bf16x8*)(Qw + d0 * 16 + hi * 8);
    const int vr = 16 * (wid & 3) + (lane >> 2);
    const bf16* kmeta = KV + (long)(ROW_M + (lane < NMETA ? lane : NMETA - 1)) * 1024 + h * NOPE + wid * 8;
    const bf16* pmeta = KPE + (long)(ROW_M + (lane < NMETA ? lane : NMETA - 1)) * ROPE + (wid & 3) * 8;
    const bf16* vmeta = KV + (long)(ROW_M + (vr < NMETA ? vr : NMETA - 1)) * 1024 + 512 + h * VHD + (wid >> 2) * 32 + (lane & 3) * 8;
    const bf16* kreal = KV + (rowbase + lane) * 1024 + h * NOPE + wid * 8;
    const bf16* preal = KPE + (rowbase + lane) * ROPE + (wid & 3) * 8;
    const bf16* vreal = KV + (rowbase + vr) * 1024 + 512 + h * VHD + (wid >> 2) * 32 + (lane & 3) * 8;
#define PA_DMA(tt, slot) do { const int tt_ = (tt); const unsigned ks_ = lds0 + LDS_K + (slot) * KSLOT, vs_ = lds0 + LDS_V + (slot) * VSLOT; \
        glds16(tt_ == 0 ? kmeta : kreal + (long)(tt_ - 1) * 64 * 1024, (unsigned)__builtin_amdgcn_readfirstlane(ks_ + wid * 1024)); \
        if (wid < 4) glds16(tt_ == 0 ? pmeta : preal + (long)(tt_ - 1) * 64 * ROPE, (unsigned)__builtin_amdgcn_readfirstlane(ks_ + (8 + wid) * 1024)); \
        glds16(tt_ == 0 ? vmeta : vreal + (long)(tt_ - 1) * 64 * 1024, (unsigned)__builtin_amdgcn_readfirstlane(vs_ + wid * 1024)); } while (0)
    f32x16 o0 = {}, o1 = {}; float mrun = -INFINITY, lsum = 0.f;
    const int qrel = wid * 32 + r32;
    PA_DMA(0, 0);
    for (int tt = 0; tt <= NT; ++tt) {
        const int slot = tt & 1;
        asm volatile("s_waitcnt vmcnt(0) lgkmcnt(0)\n\ts_barrier" ::: "memory");
        if (tt < NT) PA_DMA(tt + 1, slot ^ 1);
        const int jb = tt - 1 - (NT - 4);
        if (tt > 0 && jb >= 0 && wid < 2 * jb) continue;
        const lds_cptr kp = shm3 + LDS_K + slot * KSLOT + hi * 1024 + r32 * 16;
        f32x16 p0 = {}, p1 = {};
#pragma unroll
        for (int d0 = 0; d0 < 6; ++d0) { const bf16x8 k0 = *(const __attribute__((address_space(3))) bf16x8*)(kp + d0 * 2048), k1 = *(const __attribute__((address_space(3))) bf16x8*)(kp + d0 * 2048 + 512);
            p0 = __builtin_amdgcn_mfma_f32_32x32x16_bf16(k0, qr[d0], p0, 0, 0, 0); p1 = __builtin_amdgcn_mfma_f32_32x32x16_bf16(k1, qr[d0], p1, 0, 0, 0); }
        if (tt == 0) {
#pragma unroll
            for (int r = 0; r < 16; ++r) { if (r >= 8) p0[r] = -INFINITY; p1[r] = -INFINITY; }
        } else if (jb >= 0) { const int kb = 64 * jb + 4 * hi;
#pragma unroll
            for (int r = 0; r < 16; ++r) { const int kv = kb + (r & 3) + 8 * (r >> 2); if (kv > qrel) p0[r] = -INFINITY; if (kv + 32 > qrel) p1[r] = -INFINITY; } }
        float mt = fmaxf(p0[0], p1[0]);
#pragma unroll
        for (int r = 1; r < 16; ++r) mt = fmaxf(mt, fmaxf(p0[r], p1[r]));
        mt = swapmax(mt);
        if (__any(mt > mrun)) {
            const float mnew = fmaxf(mrun, mt), alpha = __builtin_amdgcn_exp2f(mrun - mnew); lsum *= alpha; mrun = mnew;
            if (hi == 0) wsf[r32] = alpha;
#pragma unroll
            for (int r = 0; r < 16; ++r) { const float a = wsf[crow(r, hi)]; o0[r] *= a; o1[r] *= a; }
        }
        float ps = 0.f;
#pragma unroll
        for (int r = 0; r < 16; ++r) { p0[r] = __builtin_amdgcn_exp2f(p0[r] - mrun); p1[r] = __builtin_amdgcn_exp2f(p1[r] - mrun); ps += p0[r] + p1[r]; }
        lsum += ps;
        u32x4 pw0, pw1, pw2, pw3;
        pw0 = (u32x4){cvtpk(p0[0], p0[1]), cvtpk(p0[2], p0[3]), cvtpk(p0[4], p0[5]), cvtpk(p0[6], p0[7])};
        pw1 = (u32x4){cvtpk(p0[8], p0[9]), cvtpk(p0[10], p0[11]), cvtpk(p0[12], p0[13]), cvtpk(p0[14], p0[15])};
        pw2 = (u32x4){cvtpk(p1[0], p1[1]), cvtpk(p1[2], p1[3]), cvtpk(p1[4], p1[5]), cvtpk(p1[6], p1[7])};
        pw3 = (u32x4){cvtpk(p1[8], p1[9]), cvtpk(p1[10], p1[11]), cvtpk(p1[12], p1[13]), cvtpk(p1[14], p1[15])};
        const lds_cptr vp = shm3 + LDS_V + slot * VSLOT + ((lane >> 4) & 1) * 32 + (lane & 3) * 8 + (4 * hi + ((lane & 15) >> 2)) * 64;
#define PA_VF(d0, ks) ({ const s16x4 lo_ = vtr(vp + (d0) * 4096 + (ks) * 1024), hi_ = vtr(vp + (d0) * 4096 + (ks) * 1024 + 512); (bf16x8){lo_[0], lo_[1], lo_[2], lo_[3], hi_[0], hi_[1], hi_[2], hi_[3]}; })
        o0 = __builtin_amdgcn_mfma_f32_32x32x16_bf16(__builtin_bit_cast(bf16x8, pw0), PA_VF(0, 0), o0, 0, 0, 0);
        o1 = __builtin_amdgcn_mfma_f32_32x32x16_bf16(__builtin_bit_cast(bf16x8, pw0), PA_VF(1, 0), o1, 0, 0, 0);
        o0 = __builtin_amdgcn_mfma_f32_32x32x16_bf16(__builtin_bit_cast(bf16x8, pw1), PA_VF(0, 1), o0, 0, 0, 0);
        o1 = __builtin_amdgcn_mfma_f32_32x32x16_bf16(__builtin_bit_cast(bf16x8, pw1), PA_VF(1, 1), o1, 0, 0, 0);
        o0 = __builtin_amdgcn_mfma_f32_32x32x16_bf16(__builtin_bit_cast(bf16x8, pw2), PA_VF(0, 2), o0, 0, 0, 0);
        o1 = __builtin_amdgcn_mfma_f32_32x32x16_bf16(__builtin_bit_cast(bf16x8, pw2), PA_VF(1, 2), o1, 0, 0, 0);
        o0 = __builtin_amdgcn_mfma_f32_32x32x16_bf16(__builtin_bit_cast(bf16x8, pw3), PA_VF(0, 3), o0, 0, 0, 0);
        o1 = __builtin_amdgcn_mfma_f32_32x32x16_bf16(__builtin_bit_cast(bf16x8, pw3), PA_VF(1, 3), o1, 0, 0, 0);
#undef PA_VF
    }
#undef PA_DMA
    lsum = swapsum(lsum);
    if (hi == 0) wsf[32 + r32] = lsum;
    float rli[16];
#pragma unroll
    for (int r = 0; r < 16; ++r) rli[r] = 1.0f / wsf[32 + crow(r, hi)];
    LAS bf16* stg = (LAS bf16*)(shm + LDS_OST) + wid * 2048;
#pragma unroll
    for (int r = 0; r < 16; ++r) { const int orow = crow(r, hi); const unsigned w = cvtpk(o0[r] * rli[r], o1[r] * rli[r]);
        stg[orow * 64 + r32] = (bf16)(w & 0xffffu); stg[orow * 64 + 32 + r32] = (bf16)(w >> 16); }
    bf16* Ow = O + (rowbase + q0 + wid * 32) * 512 + h * VHD;
#pragma unroll
    for (int i = 0; i < 4; ++i) { const int row = i * 8 + (lane >> 3), ch = lane & 7; const u32x4 v = *(const LAS u32x4*)(stg + row * 64 + ch * 8); *(u32x4*)(Ow + (long)row * 512 + ch * 8) = v; }
    asm volatile("s_waitcnt lgkmcnt(0)\n\ts_barrier" ::: "memory");
}

__device__ __forceinline__ void prompt_phase(int vcu, int nvcu, const bf16* Q, const bf16* KV, const bf16* KPE, bf16* O, LAS unsigned char* shm) {
    for (int v = vcu; v < 256; v += nvcu) {
        const int bh = v >> 1, b = bh >> 3, h = bh & 7, half = v & 1;
#pragma unroll 1
        for (int i = 0; i < 4; ++i) { const int qb = half == 0 ? (i == 0 ? 0 : i == 1 ? 7 : i == 2 ? 1 : 6) : (i == 0 ? 2 : i == 1 ? 5 : i == 2 ? 3 : 4);
            prompt_unit(b, h, qb, Q, KV, KPE, O, shm); }
    }
}
}

namespace dattn {
using pattn::bf16x8; using pattn::s16x4; using pattn::f32x16; using pattn::u32x4; using pattn::lds_cptr; using pattn::crow; using pattn::vtr; using pattn::cvtpk; using pattn::swapmax; using pattn::swapsum;
typedef unsigned u32x2 __attribute__((ext_vector_type(2)));
constexpr int TILE = 36864, LQ = 0, LK = TILE, LWS = 3 * TILE, LDS_END = LWS + 2048;
__device__ __forceinline__ unsigned off_a(unsigned row, unsigned ch) { return 4608u * (row >> 3) + 512u * (ch >> 2) + 64u * (row & 7) + 16u * ((ch & 3) ^ ((row >> 2) & 3)); }

__device__ __forceinline__ void decode_unit(int db, int half, const float* cache_ckv, const float* cache_kpe, const int* page_table, const bf16* Q, const bf16* QLAT, const bf16* CKV, const bf16* KPE,
                                            float* PART, LAS unsigned char* shm) {
    const int tid = threadIdx.x, lane = tid & 63, r32 = lane & 31, hi = lane >> 5; const int wid = __builtin_amdgcn_readfirstlane(tid >> 6);
    const int rb = wid & 1, kq = (wid >> 1) & 1, chalf = wid >> 2;
    LAS float* wsf = (LAS float*)(shm + LWS) + wid * 64;
    const lds_cptr shm3 = (lds_cptr)shm;
    for (int idx = tid; idx < 64 * 36; idx += 512) { const int row = idx / 36, ch = idx - row * 36, j = row >> 3, h = row & 7;
        const bf16* src = ch < 32 ? QLAT + (size_t)(db * DSEQ + j) * 2048 + h * KVL + ch * 8 : Q + (size_t)(ROW_S + db * DSEQ + j) * 768 + h * QHD + NOPE + (ch - 32) * 8;
        *(LAS u32x4*)(shm + LQ + off_a(row, ch)) = *(const u32x4*)src; }
    const int NPGH = NPG / 2, NT = NPGH * 2;
    const int myphys = page_table[db * NPG + half * NPGH + (lane & 31)];
    f32x4 st[9];
#define DA_LOAD(tt) do { const int phys_ = __builtin_amdgcn_readlane(myphys, (tt) >> 1); const size_t kb_ = (size_t)phys_ * PAGE + ((tt) & 1) * 64; \
        _Pragma("unroll") for (int i = 0; i < 8; ++i) st[i] = *(const f32x4*)(cache_ckv + (kb_ + i * 8 + wid) * KVL + 4 * lane); \
        st[8] = *(const f32x4*)(cache_kpe + (kb_ + (tid >> 3)) * ROPE + 4 * (tid & 7)); } while (0)
#define DA_STORE(buf) do { LAS unsigned char* kb_ = shm + LK + (buf) * TILE; \
        _Pragma("unroll") for (int i = 0; i < 8; ++i) { u32x2 w; w.x = cvtpk(st[i].x, st[i].y); w.y = cvtpk(st[i].z, st[i].w); *(LAS u32x2*)(kb_ + off_a(i * 8 + wid, lane >> 1) + 8 * (lane & 1)) = w; } \
        { u32x2 w; w.x = cvtpk(st[8].x, st[8].y); w.y = cvtpk(st[8].z, st[8].w); *(LAS u32x2*)(kb_ + off_a(tid >> 3, 32 + ((tid & 7) >> 1)) + 8 * (tid & 1)) = w; } } while (0)
    f32x16 o[4] = {{}, {}, {}, {}}; float mrun = -INFINITY, lsum = 0.f;
    const unsigned krow = 32 * kq + r32, qrow = 32 * rb + r32;
    const unsigned vq = (lane & 15) >> 2, vp_ = lane & 3, vblk = (lane >> 4) & 1;
#define DA_COMPUTE(buf, NEWTILE) do { \
        const lds_cptr kbase = shm3 + LK + (buf) * TILE; const lds_cptr qbase = shm3 + LQ; \
        f32x16 p = {}; \
        _Pragma("unroll") for (int s = 0; s < 18; ++s) { const bf16x8 kf = *(const __attribute__((address_space(3))) bf16x8*)(kbase + off_a(krow, 2 * s + hi)); \
            const bf16x8 qf = *(const __attribute__((address_space(3))) bf16x8*)(qbase + off_a(qrow, 2 * s + hi)); p = __builtin_amdgcn_mfma_f32_32x32x16_bf16(kf, qf, p, 0, 0, 0); } \
        if (NEWTILE) { const int tok = (int)qrow >> 3; _Pragma("unroll") for (int r = 0; r < 16; ++r) { const int key = crow(r, hi); if (key >= DSEQ || key > tok) p[r] = -INFINITY; } } \
        float mt = p[0]; _Pragma("unroll") for (int r = 1; r < 16; ++r) mt = fmaxf(mt, p[r]); \
        mt = swapmax(mt); \
        if (__any(mt > mrun)) { const float mnew = fmaxf(mrun, mt), alpha = __builtin_amdgcn_exp2f(mrun - mnew); lsum *= alpha; mrun = mnew; \
            if (hi == 0) wsf[r32] = alpha; \
            _Pragma("unroll") for (int r = 0; r < 16; ++r) { const float a = wsf[crow(r, hi)]; o[0][r] *= a; o[1][r] *= a; o[2][r] *= a; o[3][r] *= a; } } \
        float ps = 0.f; _Pragma("unroll") for (int r = 0; r < 16; ++r) { p[r] = __builtin_amdgcn_exp2f(p[r] - mrun); ps += p[r]; } \
        lsum += ps; \
        const u32x4 pw0 = (u32x4){cvtpk(p[0], p[1]), cvtpk(p[2], p[3]), cvtpk(p[4], p[5]), cvtpk(p[6], p[7])}, pw1 = (u32x4){cvtpk(p[8], p[9]), cvtpk(p[10], p[11]), cvtpk(p[12], p[13]), cvtpk(p[14], p[15])}; \
        _Pragma("unroll") for (int s = 0; s < 2; ++s) _Pragma("unroll") for (int c4 = 0; c4 < 4; ++c4) { const unsigned cb = 4 * chalf + c4; \
            const s16x4 lo_ = vtr(kbase + off_a(32 * kq + 16 * s + 4 * hi + vq, 4 * cb + 2 * vblk + (vp_ >> 1)) + 8 * (vp_ & 1)), \
                        hi_ = vtr(kbase + off_a(32 * kq + 16 * s + 8 + 4 * hi + vq, 4 * cb + 2 * vblk + (vp_ >> 1)) + 8 * (vp_ & 1)); \
            const bf16x8 vf = (bf16x8){lo_[0], lo_[1], lo_[2], lo_[3], hi_[0], hi_[1], hi_[2], hi_[3]}; \
            o[c4] = __builtin_amdgcn_mfma_f32_32x32x16_bf16(__builtin_bit_cast(bf16x8, s == 0 ? pw0 : pw1), vf, o[c4], 0, 0, 0); } \
    } while (0)
    DA_LOAD(0);
    DA_STORE(0);
    asm volatile("s_waitcnt lgkmcnt(0)\n\ts_barrier" ::: "memory");
#pragma unroll 1
    for (int tt = 0; tt < NT; ++tt) {
        const int buf = tt & 1;
        if (tt + 1 < NT) DA_LOAD(tt + 1);
        DA_COMPUTE(buf, false);
        if (tt + 1 < NT) DA_STORE(buf ^ 1);
        asm volatile("s_waitcnt lgkmcnt(0)\n\ts_barrier" ::: "memory");
    }
    if (half == 1) {
        if (tid < DSEQ * 36) { const int key = tid / 36, ch = tid - key * 36; const size_t krow_g = (size_t)ROW_S + db * DSEQ + key;
            const bf16* src = ch < 32 ? CKV + krow_g * KVL + ch * 8 : KPE + krow_g * ROPE + (ch - 32) * 8;
            *(LAS u32x4*)(shm + LK + off_a(key, ch)) = *(const u32x4*)src; }
        asm volatile("s_waitcnt vmcnt(0) lgkmcnt(0)\n\ts_barrier" ::: "memory");
        if (kq == 0) DA_COMPUTE(0, true);
    }
#undef DA_LOAD
#undef DA_STORE
#undef DA_COMPUTE
    lsum = swapsum(lsum);
    float* dst = PART + ((size_t)(db * NSPLIT + half * 2 + kq) * 64 + 32 * rb) * 264;
#pragma unroll
    for (int c4 = 0; c4 < 4; ++c4)
#pragma unroll
        for (int r = 0; r < 16; ++r) dst[(size_t)crow(r, hi) * 264 + 32 * (4 * chalf + c4) + r32] = o[c4][r];
    if (chalf == 0 && hi == 0) { dst[(size_t)r32 * 264 + 256] = mrun; dst[(size_t)r32 * 264 + 257] = lsum; }
    asm volatile("s_waitcnt lgkmcnt(0)\n\ts_barrier" ::: "memory");
}
}
struct Frame {
    LAS unsigned char* lds;
    volatile LAS unsigned* MISC;
    gu32* ctl;
    int tid, lane, wave;
    int vcu, G;
    const float *x_prompt, *x_sample, *cache_ckv, *cache_kpe, *state_conv; const int* page_table; const float *meta, *lne_g, *lne_b, *w_in, *qn_g, *w_uq, *kvn_g, *w_uk, *w_uv, *w_o_mla,
        *conv_w, *w_conv_out, *w_o, *ln1_g, *ln1_b, *w_up, *w_down, *ln2_g, *ln2_b;
    float* out; unsigned char* ws;
};
#define WSP(T, off) ((T*)(F.ws + (off)))

__device__ __forceinline__ float wave_sum(float v) {
#pragma unroll
    for (int o = 1; o < 64; o <<= 1) v += __shfl_xor(v, o);
    return v;
}
__device__ __forceinline__ float bf2f(unsigned short h) { return __uint_as_float((unsigned)h << 16); }
__device__ __forceinline__ float bflo(unsigned u) { return __uint_as_float(u << 16); }
__device__ __forceinline__ float bfhi(unsigned u) { return __uint_as_float(u & 0xffff0000u); }

__device__ __forceinline__ void p0_transpose_item(const float* W, int ldw, bf16* WT, int ldt, int k0, int srcn0, int dstn0, LAS float* scr, int lane) {
    if (srcn0 >= 0) {
#pragma unroll 8
        for (int i = 0; i < 32; ++i) { const int kk = 2 * i + (lane >> 5); scr[kk * 33 + (lane & 31)] = W[(size_t)(k0 + kk) * ldw + srcn0 + (lane & 31)]; }
    } else {
#pragma unroll 8
        for (int i = 0; i < 32; ++i) { const int kk = 2 * i + (lane >> 5); scr[kk * 33 + (lane & 31)] = 0.f; }
    }
    LDS_WAIT(); asm volatile("" ::: "memory");
    const int c = lane & 7;
#pragma unroll
    for (int j = 0; j < 4; ++j) { const int n = (lane >> 3) + 8 * j; const LAS float* s = scr + (8 * c) * 33 + n;
        v4u o; o.x = pk2(s[0 * 33], s[1 * 33]); o.y = pk2(s[2 * 33], s[3 * 33]); o.z = pk2(s[4 * 33], s[5 * 33]); o.w = pk2(s[6 * 33], s[7 * 33]);
        *(GAS v4u*)(WT + (size_t)(dstn0 + n) * ldt + k0 + 8 * c) = o; }
    LDS_WAIT(); asm volatile("" ::: "memory");
}
__device__ __forceinline__ int win_src_col(int n) {
    if (n < 384) return ZC_CQ + n;
    if (n < 416) return ZC_KPE + (n - 384);
    if (n < 512) return -1;
    if (n < 768) return ZC_CKV + (n - 512);
    if (n < 1280) return ZC_GB + (n - 768);
    if (n < 2304) { const int q = n - 1280, p = q >> 8, j = q & 255; return j < 128 ? ZC_GC + 128 * p + j : ZC_CH + 128 * p + (j - 128); }
    if (n < 3328) return ZC_GCV + (n - 2304);
    return ZC_GML + (n - 3328);
}
__device__ __forceinline__ void sincos_d(double a, double& s, double& c) {
    const double n = __builtin_rint(a * 0.63661977236758138);
    double r = __builtin_fma(-n, 1.5707963267948966, a); r = __builtin_fma(-n, 6.123233995736766e-17, r);
    const double r2 = r * r;
    double sp = -1.0 / 1307674368000.0; sp = sp * r2 + 1.0 / 6227020800.0; sp = sp * r2 - 1.0 / 39916800.0; sp = sp * r2 + 1.0 / 362880.0; sp = sp * r2 - 1.0 / 5040.0; sp = sp * r2 + 1.0 / 120.0; sp = sp * r2 - 1.0 / 6.0; sp = sp * r2 + 1.0; sp *= r;
    double cp = 1.0 / 20922789888000.0; cp = cp * r2 - 1.0 / 87178291200.0; cp = cp * r2 + 1.0 / 479001600.0; cp = cp * r2 - 1.0 / 3628800.0; cp = cp * r2 + 1.0 / 40320.0; cp = cp * r2 - 1.0 / 720.0; cp = cp * r2 + 1.0 / 24.0; cp = cp * r2 - 0.5; cp = cp * r2 + 1.0;
    const int q = ((int)n) & 3;
    s = (q == 0) ? sp : (q == 1) ? cp : (q == 2) ? -sp : -cp;
    c = (q == 0) ? cp : (q == 1) ? -sp : (q == 2) ? -cp : sp;
}
__device__ __forceinline__ void ln_row(f32x4 (&v)[4], const float* g, const float* b, int lane) {
    float s = 0.f;
#pragma unroll
    for (int j = 0; j < 4; ++j) s += (v[j].x + v[j].y) + (v[j].z + v[j].w);
    const float mean = wave_sum(s) * (1.f / D); float s2 = 0.f;
#pragma unroll
    for (int j = 0; j < 4; ++j) { v[j] = v[j] - mean; s2 += (v[j].x * v[j].x + v[j].y * v[j].y) + (v[j].z * v[j].z + v[j].w * v[j].w); }
    const float rstd = 1.f / sqrtf(wave_sum(s2) * (1.f / D) + LN_EPS);
#pragma unroll
    for (int j = 0; j < 4; ++j) { const f32x4 gg = *(const f32x4*)(g + 4 * lane + 256 * j), bb = *(const f32x4*)(b + 4 * lane + 256 * j); v[j] = v[j] * rstd * gg + bb; }
}

__device__ __forceinline__ void p0_prologue(Frame& F) {
    LAS float* scr = (LAS float*)(F.lds + RING_OFF + F.wave * 16384);
    const int gw = F.vcu * NWAVES + F.wave, NGW = F.G * NWAVES, lane = F.lane;
    constexpr int I_IN = (D / 64) * (NZ / 32), I_UQ = (QLORA / 64) * (768 / 32), I_KV = (KVL / 64) * (1024 / 32), I_CO = (CDIM / 64) * (D / 32), I_OM = (512 / 64) * (D / 32),
                  I_O = (D / 64) * (D / 32), I_UP = (D / 64) * (FF / 32), I_DN = (FF / 64) * (D / 32);
    constexpr int NITEMS = I_IN + I_UQ + I_KV + I_CO + I_OM + I_O + I_UP + I_DN;
    for (int it = gw; it < NITEMS; it += NGW) {
        int r = it;
        if (r < I_IN) { const int nb = r % (NZ / 32), kb = r / (NZ / 32); p0_transpose_item(F.w_in, DIN, WSP(bf16, WS_WIN), D, 64 * kb, win_src_col(32 * nb), 32 * nb, scr, lane); continue; } r -= I_IN;
        if (r < I_UQ) { const int nb = r % 24, kb = r / 24; p0_transpose_item(F.w_uq, 768, WSP(bf16, WS_WUQ), QLORA, 64 * kb, 32 * nb, 32 * nb, scr, lane); continue; } r -= I_UQ;
        if (r < I_KV) { const int nb = r % 32, kb = r / 32; p0_transpose_item(nb < 16 ? F.w_uk : F.w_uv, 512, WSP(bf16, WS_WKV), KVL, 64 * kb, 32 * (nb & 15), 32 * nb, scr, lane); continue; } r -= I_KV;
        if (r < I_CO) { const int nb = r % 32, kb = r / 32; p0_transpose_item(F.w_conv_out, D, WSP(bf16, WS_WCO), CDIM, 64 * kb, 32 * nb, 32 * nb, scr, lane); continue; } r -= I_CO;
        if (r < I_OM) { const int nb = r % 32, kb = r / 32; p0_transpose_item(F.w_o_mla, D, WSP(bf16, WS_WOM), 512, 64 * kb, 32 * nb, 32 * nb, scr, lane); continue; } r -= I_OM;
        if (r < I_O) { const int nb = r % 32, kb = r / 32; p0_transpose_item(F.w_o, D, WSP(bf16, WS_WO), D, 64 * kb, 32 * nb, 32 * nb, scr, lane); continue; } r -= I_O;
        if (r < I_UP) { const int nb = r % 128, kb = r / 128; p0_transpose_item(F.w_up, FF, WSP(bf16, WS_WUP), D, 64 * kb, 32 * nb, 32 * nb, scr, lane); continue; } r -= I_UP;
        { const int nb = r % 32, kb = r / 32; p0_transpose_item(F.w_down, D, WSP(bf16, WS_WDN), FF, 64 * kb, 32 * nb, 32 * nb, scr, lane); }
    }
    for (int n = gw; n < NH * KVL; n += NGW) {
        const int h = n >> 8, c = n & 255; const float* uk = F.w_uk + (size_t)c * 512 + h * 64;
        bf16* dst = WSP(bf16, WS_WABS) + (size_t)n * QLORA;
        for (int j = 0; j < QLORA / 64; ++j) { const int k = lane + 64 * j; const float* uq = F.w_uq + (size_t)k * 768 + h * 96; float s = 0.f;
#pragma unroll 4
            for (int i = 0; i < 16; ++i) { const f32x4 a = *(const f32x4*)(uq + 4 * i), b = *(const f32x4*)(uk + 4 * i); s += (a.x * b.x + a.y * b.y) + (a.z * b.z + a.w * b.w); }
            dst[k] = (bf16)f2bf(s); }
    }
    for (int e = F.vcu * (NWAVES * 64) + F.tid; e < NTAB * 16; e += F.G * NWAVES * 64) {
        const int tp = e >> 4, i = e & 15; const int pos = tp < LP ? tp : PAST + (tp - LP);
        double inv = 1.0; for (int j = 0; j < i; ++j) inv *= 0.56234132519034908;
        const float inv_f = (float)inv; const float ang = (float)pos * inv_f;
        double s, c; sincos_d((double)ang, s, c);
        float* t = WSP(float, WS_TAB) + (size_t)tp * 32; t[i] = (float)c; t[16 + i] = (float)s;
    }
    for (int m = gw; m < M_ALL; m += NGW) {
        GAS unsigned long long* o8 = (GAS unsigned long long*)(WSP(bf16, WS_XN) + (size_t)m * D) + lane;
        GAS f32x4* h4 = (GAS f32x4*)(WSP(float, WS_H32) + (size_t)m * D) + lane;
        if (m >= ROW_M + NMETA) {
#pragma unroll
            for (int j = 0; j < 4; ++j) { o8[64 * j] = 0ull; h4[64 * j] = (f32x4){0.f, 0.f, 0.f, 0.f}; }
            continue; }
        const float* xrow = m < M_P ? F.x_prompt + (size_t)m * D : (m < ROW_M ? F.x_sample + (size_t)(m - ROW_S) * D : F.meta + (size_t)(m - ROW_M) * D);
        const GAS f32x4* xr = (const GAS f32x4*)xrow + lane;
        f32x4 v[4];
#pragma unroll
        for (int j = 0; j < 4; ++j) v[j] = xr[64 * j];
        ln_row(v, F.lne_g, F.lne_b, lane);
#pragma unroll
        for (int j = 0; j < 4; ++j) { h4[64 * j] = v[j]; o8[64 * j] = (unsigned long long)pk2(v[j].x, v[j].y) | ((unsigned long long)pk2(v[j].z, v[j].w) << 32); }
    }
}

__device__ __forceinline__ void p2_thin(Frame& F) {
    const int gw = F.vcu * NWAVES + F.wave, NGW = F.G * NWAVES, lane = F.lane;
    const float* ZF = WSP(float, WS_ZF); const bf16* GB = WSP(bf16, WS_GB); const bf16* U = WSP(bf16, WS_U);
    for (int m = gw; m < ROW_M + NMETA; m += NGW) {
        const float* z = ZF + (size_t)m * 768;
        { const f32x4 a = *(const f32x4*)(z + 4 * lane); const float b0 = z[256 + 2 * lane], b1 = z[256 + 2 * lane + 1];
          const float ss = wave_sum((a.x * a.x + a.y * a.y) + (a.z * a.z + a.w * a.w) + (b0 * b0 + b1 * b1));
          const float sc = 1.f / sqrtf(ss * (1.f / QLORA) + RMS_EPS);
          const f32x4 g = *(const f32x4*)(F.qn_g + 4 * lane); const float g0 = F.qn_g[256 + 2 * lane], g1 = F.qn_g[256 + 2 * lane + 1];
          bf16* o = WSP(bf16, WS_CQN) + (size_t)m * QLORA;
          *(unsigned long long*)(o + 4 * lane) = (unsigned long long)pk2(a.x * sc * g.x, a.y * sc * g.y) | ((unsigned long long)pk2(a.z * sc * g.z, a.w * sc * g.w) << 32);
          *(unsigned*)(o + 256 + 2 * lane) = pk2(b0 * sc * g0, b1 * sc * g1); }
        { const f32x4 a = *(const f32x4*)(z + 512 + 4 * lane);
          const float ss = wave_sum((a.x * a.x + a.y * a.y) + (a.z * a.z + a.w * a.w));
          const float sc = 1.f / sqrtf(ss * (1.f / KVL) + RMS_EPS);
          const f32x4 g = *(const f32x4*)(F.kvn_g + 4 * lane); const f32x4 v = a * sc * g;
          *(unsigned long long*)(WSP(bf16, WS_CKV) + (size_t)m * KVL + 4 * lane) = (unsigned long long)pk2(v.x, v.y) | ((unsigned long long)pk2(v.z, v.w) << 32);
          if (m < M_P) *(f32x4*)(F.out + O_CKVP + ((size_t)(m >> 11) * LP + NMETA + (m & (SEQ - 1))) * KVL + 4 * lane) = v;
          else if (m < ROW_M) *(f32x4*)(F.out + O_CKVS + (size_t)(m - ROW_S) * KVL + 4 * lane) = v;
          else for (int b = 0; b < NB; ++b) *(f32x4*)(F.out + O_CKVP + ((size_t)b * LP + (m - ROW_M)) * KVL + 4 * lane) = v; }
        if (lane < 16) { const float x1 = z[384 + lane], x2 = z[384 + 16 + lane]; const float* t = WSP(float, WS_TAB) + (size_t)epi::tab_pos(m) * 32; const float cs = t[lane], sn = t[16 + lane];
          const float y1 = x1 * cs - x2 * sn, y2 = x2 * cs + x1 * sn;
          bf16* o = WSP(bf16, WS_KPE) + (size_t)m * ROPE; o[lane] = (bf16)f2bf(y1); o[16 + lane] = (bf16)f2bf(y2);
          if (m < M_P) { float* p = F.out + O_KPEP + ((size_t)(m >> 11) * LP + NMETA + (m & (SEQ - 1))) * ROPE; p[lane] = y1; p[16 + lane] = y2; }
          else if (m < ROW_M) { float* p = F.out + O_KPES + (size_t)(m - ROW_S) * ROPE; p[lane] = y1; p[16 + lane] = y2; }
          else for (int b = 0; b < NB; ++b) { float* p = F.out + O_KPEP + ((size_t)b * LP + (m - ROW_M)) * ROPE; p[lane] = y1; p[16 + lane] = y2; } }
        if (m < ROW_M) {
            const int c0 = 8 * lane; float u0[8], u1[8], u2[8];
            { const v4u r = *(const v4u*)(U + (size_t)m * CDIM + c0); u0[0] = bflo(r.x); u0[1] = bfhi(r.x); u0[2] = bflo(r.y); u0[3] = bfhi(r.y); u0[4] = bflo(r.z); u0[5] = bfhi(r.z); u0[6] = bflo(r.w); u0[7] = bfhi(r.w); }
#pragma unroll
            for (int d = 1; d <= 2; ++d) { float* dst = d == 1 ? u1 : u2; int src = -1; const float* st = nullptr;
                if (m < M_P) { const int t = m & (SEQ - 1); src = t >= d ? m - d : ROW_M + NMETA - (d - t); }
                else { const int j = (m - ROW_S) & 7, db = (m - ROW_S) >> 3; if (j >= d) src = m - d; else st = F.state_conv + ((size_t)db * 2 + (2 - (d - j))) * CDIM; }
                if (src >= 0) { const v4u r = *(const v4u*)(U + (size_t)src * CDIM + c0); dst[0] = bflo(r.x); dst[1] = bfhi(r.x); dst[2] = bflo(r.y); dst[3] = bfhi(r.y); dst[4] = bflo(r.z); dst[5] = bfhi(r.z); dst[6] = bflo(r.w); dst[7] = bfhi(r.w); }
                else { const f32x4 a = *(const f32x4*)(st + c0), b = *(const f32x4*)(st + c0 + 4); dst[0] = a.x; dst[1] = a.y; dst[2] = a.z; dst[3] = a.w; dst[4] = b.x; dst[5] = b.y; dst[6] = b.z; dst[7] = b.w; } }
            const v4u gr = *(const v4u*)(GB + (size_t)m * CDIM + c0); float gb[8] = {bflo(gr.x), bfhi(gr.x), bflo(gr.y), bfhi(gr.y), bflo(gr.z), bfhi(gr.z), bflo(gr.w), bfhi(gr.w)};
            float r[8];
#pragma unroll
            for (int e = 0; e < 8; ++e) { const float w0 = F.conv_w[c0 + e], w1 = F.conv_w[CDIM + c0 + e], w2 = F.conv_w[2 * CDIM + c0 + e]; r[e] = gb[e] * (w0 * u2[e] + w1 * u1[e] + w2 * u0[e]); }
            v4u o; o.x = pk2(r[0], r[1]); o.y = pk2(r[2], r[3]); o.z = pk2(r[4], r[5]); o.w = pk2(r[6], r[7]);
            *(v4u*)(WSP(bf16, WS_CV) + (size_t)m * CDIM + c0) = o;
        }
    }
}

__device__ __forceinline__ void attn_prompt_naive(Frame& F) {
    const bf16* Q = WSP(bf16, WS_Q); const bf16* KV = WSP(bf16, WS_KV); const bf16* KPE = WSP(bf16, WS_KPE); bf16* O = WSP(bf16, WS_O);
    for (int v = blockIdx.x; v < 256; v += F.G) {
        const int bh = v >> 1, b = bh >> 3, h = bh & 7;
        for (int ii = 0; ii < 2; ++ii) {
            const int qblk = (v & 1) ? (1 + ii) : (3 * ii);
            const int t = qblk * 512 + F.tid; const size_t row = (size_t)b * SEQ + t;
            float q[QHD], o[VHD]; float mx = -INFINITY, l = 0.f;
            { const v4u* qp = (const v4u*)(Q + row * 768 + h * QHD);
#pragma unroll
              for (int i = 0; i < QHD / 8; ++i) { const v4u r = qp[i]; q[8 * i] = bflo(r.x); q[8 * i + 1] = bfhi(r.x); q[8 * i + 2] = bflo(r.y); q[8 * i + 3] = bfhi(r.y); q[8 * i + 4] = bflo(r.z); q[8 * i + 5] = bfhi(r.z); q[8 * i + 6] = bflo(r.w); q[8 * i + 7] = bfhi(r.w); } }
#pragma unroll
            for (int d = 0; d < VHD; ++d) o[d] = 0.f;
            const int tmax = qblk * 512 + F.wave * 64 + 63;
            for (int kk = -NMETA; kk <= tmax; ++kk) {
                const size_t krow = kk < 0 ? (size_t)(ROW_M + NMETA + kk) : (size_t)b * SEQ + kk;
                const v4u* kp = (const v4u*)(KV + krow * 1024 + h * NOPE); const v4u* pp = (const v4u*)(KPE + krow * ROPE); const v4u* vp = (const v4u*)(KV + krow * 1024 + 512 + h * VHD);
                float s = 0.f;
#pragma unroll
                for (int i = 0; i < 8; ++i) { const v4u r = kp[i]; s += q[8 * i] * bflo(r.x) + q[8 * i + 1] * bfhi(r.x) + q[8 * i + 2] * bflo(r.y) + q[8 * i + 3] * bfhi(r.y) + q[8 * i + 4] * bflo(r.z) + q[8 * i + 5] * bfhi(r.z) + q[8 * i + 6] * bflo(r.w) + q[8 * i + 7] * bfhi(r.w); }
#pragma unroll
                for (int i = 0; i < 4; ++i) { const v4u r = pp[i]; const int j = 64 + 8 * i; s += q[j] * bflo(r.x) + q[j + 1] * bfhi(r.x) + q[j + 2] * bflo(r.y) + q[j + 3] * bfhi(r.y) + q[j + 4] * bflo(r.z) + q[j + 5] * bfhi(r.z) + q[j + 6] * bflo(r.w) + q[j + 7] * bfhi(r.w); }
                if (kk <= t) {
                    if (s > mx) { const float a = __builtin_amdgcn_exp2f(mx - s); l *= a;
#pragma unroll
                        for (int d = 0; d < VHD; ++d) o[d] *= a;
                        mx = s; }
                    const float p = __builtin_amdgcn_exp2f(s - mx); l += p;
#pragma unroll
                    for (int i = 0; i < 8; ++i) { const v4u r = vp[i]; o[8 * i] += p * bflo(r.x); o[8 * i + 1] += p * bfhi(r.x); o[8 * i + 2] += p * bflo(r.y); o[8 * i + 3] += p * bfhi(r.y); o[8 * i + 4] += p * bflo(r.z); o[8 * i + 5] += p * bfhi(r.z); o[8 * i + 6] += p * bflo(r.w); o[8 * i + 7] += p * bfhi(r.w); }
                }
            }
            const float il = 1.f / l; v4u* op = (v4u*)(O + row * 512 + h * VHD);
#pragma unroll
            for (int i = 0; i < 8; ++i) { v4u w; w.x = pk2(o[8 * i] * il, o[8 * i + 1] * il); w.y = pk2(o[8 * i + 2] * il, o[8 * i + 3] * il); w.z = pk2(o[8 * i + 4] * il, o[8 * i + 5] * il); w.w = pk2(o[8 * i + 6] * il, o[8 * i + 7] * il); op[i] = w; }
        }
    }
}

__device__ __forceinline__ void attn_decode_naive(Frame& F) {
    const bf16* Q = WSP(bf16, WS_Q); const bf16* QLAT = WSP(bf16, WS_QLAT); const bf16* CKV = WSP(bf16, WS_CKV); const bf16* KPE = WSP(bf16, WS_KPE); float* PART = WSP(float, WS_PART);
    const int r = F.tid >> 3, part = F.tid & 7, j = r >> 3, h = r & 7;
    for (int uu = blockIdx.x; uu < DBATCH * NSPLIT; uu += F.G) {
        const int db = uu / NSPLIT, ck = uu % NSPLIT;
        float ql[32], qp[4], o[32]; float mx = -INFINITY, l = 0.f;
        { const v4u* p = (const v4u*)(QLAT + (size_t)(db * DSEQ + j) * 2048 + h * KVL + part * 32);
#pragma unroll
          for (int i = 0; i < 4; ++i) { const v4u w = p[i]; ql[8 * i] = bflo(w.x); ql[8 * i + 1] = bfhi(w.x); ql[8 * i + 2] = bflo(w.y); ql[8 * i + 3] = bfhi(w.y); ql[8 * i + 4] = bflo(w.z); ql[8 * i + 5] = bfhi(w.z); ql[8 * i + 6] = bflo(w.w); ql[8 * i + 7] = bfhi(w.w); }
          const unsigned long long w = *(const unsigned long long*)(Q + (size_t)(ROW_S + db * DSEQ + j) * 768 + h * QHD + NOPE + part * 4);
          qp[0] = bflo((unsigned)w); qp[1] = bfhi((unsigned)w); qp[2] = bflo((unsigned)(w >> 32)); qp[3] = bfhi((unsigned)(w >> 32)); }
#pragma unroll
        for (int d = 0; d < 32; ++d) o[d] = 0.f;
        const int npg = NPG / NSPLIT;
        for (int pg = ck * npg; pg < (ck + 1) * npg; ++pg) {
            const int phys = F.page_table[db * NPG + pg];
            const float* cb = F.cache_ckv + (size_t)phys * PAGE * KVL + part * 32; const float* pb = F.cache_kpe + (size_t)phys * PAGE * ROPE + part * 4;
            for (int kk = 0; kk < PAGE; ++kk) {
                float kv[32]; const f32x4* cp = (const f32x4*)(cb + (size_t)kk * KVL);
#pragma unroll
                for (int i = 0; i < 8; ++i) { const f32x4 w = cp[i]; kv[4 * i] = w.x; kv[4 * i + 1] = w.y; kv[4 * i + 2] = w.z; kv[4 * i + 3] = w.w; }
                const f32x4 kp = *(const f32x4*)(pb + (size_t)kk * ROPE);
                float s = qp[0] * kp.x + qp[1] * kp.y + qp[2] * kp.z + qp[3] * kp.w;
#pragma unroll
                for (int d = 0; d < 32; ++d) s += ql[d] * kv[d];
                s += __shfl_xor(s, 1); s += __shfl_xor(s, 2); s += __shfl_xor(s, 4);
                if (s > mx) { const float a = __builtin_amdgcn_exp2f(mx - s); l *= a;
#pragma unroll
                    for (int d = 0; d < 32; ++d) o[d] *= a;
                    mx = s; }
                const float p = __builtin_amdgcn_exp2f(s - mx); l += p;
#pragma unroll
                for (int d = 0; d < 32; ++d) o[d] += p * kv[d];
            }
        }
        if (ck == NSPLIT - 1) {
            for (int jj = 0; jj < DSEQ; ++jj) {
                const size_t krow = (size_t)ROW_S + db * DSEQ + jj; float kv[32];
                const v4u* cp = (const v4u*)(CKV + krow * KVL + part * 32);
#pragma unroll
                for (int i = 0; i < 4; ++i) { const v4u w = cp[i]; kv[8 * i] = bflo(w.x); kv[8 * i + 1] = bfhi(w.x); kv[8 * i + 2] = bflo(w.y); kv[8 * i + 3] = bfhi(w.y); kv[8 * i + 4] = bflo(w.z); kv[8 * i + 5] = bfhi(w.z); kv[8 * i + 6] = bflo(w.w); kv[8 * i + 7] = bfhi(w.w); }
                const unsigned long long w = *(const unsigned long long*)(KPE + krow * ROPE + part * 4);
                float s = qp[0] * bflo((unsigned)w) + qp[1] * bfhi((unsigned)w) + qp[2] * bflo((unsigned)(w >> 32)) + qp[3] * bfhi((unsigned)(w >> 32));
#pragma unroll
                for (int d = 0; d < 32; ++d) s += ql[d] * kv[d];
                s += __shfl_xor(s, 1); s += __shfl_xor(s, 2); s += __shfl_xor(s, 4);
                if (jj <= j) {
                    if (s > mx) { const float a = __builtin_amdgcn_exp2f(mx - s); l *= a;
#pragma unroll
                        for (int d = 0; d < 32; ++d) o[d] *= a;
                        mx = s; }
                    const float p = __builtin_amdgcn_exp2f(s - mx); l += p;
#pragma unroll
                    for (int d = 0; d < 32; ++d) o[d] += p * kv[d];
                }
            }
        }
        float* dst = PART + ((size_t)(db * NSPLIT + ck) * 64 + r) * 264;
#pragma unroll
        for (int i = 0; i < 8; ++i) *(f32x4*)(dst + part * 32 + 4 * i) = (f32x4){o[4 * i], o[4 * i + 1], o[4 * i + 2], o[4 * i + 3]};
        if (part == 0) { dst[256] = mx; dst[257] = l; }
    }
}

__device__ __forceinline__ void decode_combine(Frame& F) {
    const float* PART = WSP(float, WS_PART); bf16* O = WSP(bf16, WS_O);
    LAS float* OL = (LAS float*)(F.lds + RING_OFF);
    const int r = F.tid >> 3, part = F.tid & 7, j = r >> 3, h = r & 7;
    for (int db = blockIdx.x; db < DBATCH; db += F.G) {
        const float* src0 = PART + ((size_t)db * NSPLIT * 64 + r) * 264;
        float M = -INFINITY;
#pragma unroll 1
        for (int k = 0; k < NSPLIT; ++k) M = fmaxf(M, src0[(size_t)k * 64 * 264 + 256]);
        float L = 0.f, o[32];
#pragma unroll
        for (int d = 0; d < 32; ++d) o[d] = 0.f;
#pragma unroll 1
        for (int k = 0; k < NSPLIT; ++k) { const float* src = src0 + (size_t)k * 64 * 264; const float a = __builtin_amdgcn_exp2f(src[256] - M); L += src[257] * a;
#pragma unroll
            for (int i = 0; i < 8; ++i) { const f32x4 w = *(const f32x4*)(src + part * 32 + 4 * i); o[4 * i] += a * w.x; o[4 * i + 1] += a * w.y; o[4 * i + 2] += a * w.z; o[4 * i + 3] += a * w.w; } }
        const float il = 1.f / L;
#pragma unroll
        for (int d = 0; d < 32; ++d) OL[r * 260 + part * 32 + d] = o[d] * il;
        __syncthreads();
        float acc[8];
#pragma unroll
        for (int e = 0; e < 8; ++e) acc[e] = 0.f;
        const float* wv = F.w_uv + h * VHD + part * 8;
        for (int c = 0; c < KVL; ++c) { const float x = OL[r * 260 + c]; const f32x4 a = *(const f32x4*)(wv + (size_t)c * 512), b = *(const f32x4*)(wv + (size_t)c * 512 + 4);
            acc[0] += x * a.x; acc[1] += x * a.y; acc[2] += x * a.z; acc[3] += x * a.w; acc[4] += x * b.x; acc[5] += x * b.y; acc[6] += x * b.z; acc[7] += x * b.w; }
        v4u w; w.x = pk2(acc[0], acc[1]); w.y = pk2(acc[2], acc[3]); w.z = pk2(acc[4], acc[5]); w.w = pk2(acc[6], acc[7]);
        *(v4u*)(O + (size_t)(ROW_S + db * DSEQ + j) * 512 + h * VHD + part * 8) = w;
        __syncthreads();
    }
}

__device__ __forceinline__ void ln_pass(Frame& F, const float* R, const float* g, const float* b, float* dst32, bf16* dst16, int nrows) {
    const int gw = F.vcu * NWAVES + F.wave, NGW = F.G * NWAVES, lane = F.lane;
    for (int m = gw; m < nrows; m += NGW) {
        const GAS f32x4* xr = (const GAS f32x4*)(R + (size_t)m * D) + lane; f32x4 v[4];
#pragma unroll
        for (int j = 0; j < 4; ++j) v[j] = xr[64 * j];
        ln_row(v, g, b, lane);
        GAS f32x4* o4 = (GAS f32x4*)(dst32 + (size_t)m * D) + lane;
#pragma unroll
        for (int j = 0; j < 4; ++j) o4[64 * j] = v[j];
        if (dst16) { GAS unsigned long long* o8 = (GAS unsigned long long*)(dst16 + (size_t)m * D) + lane;
#pragma unroll
            for (int j = 0; j < 4; ++j) o8[64 * j] = (unsigned long long)pk2(v[j].x, v[j].y) | ((unsigned long long)pk2(v[j].z, v[j].w) << 32); }
    }
}
#ifndef MK_N_LAUNCHES
#define MK_N_LAUNCHES 1
#endif
constexpr int NPHASE = 13;
struct Args { const void* in[25]; float* out; unsigned char* ws; int ph_lo, ph_hi; };
__global__ void __launch_bounds__(NWAVES * 64, 2) fwd_kernel(Args args) {
    extern __shared__ __attribute__((aligned(16))) unsigned char lds[];
    Frame F;
    F.lds = (LAS unsigned char*)lds;
    F.MISC = (volatile LAS unsigned*)(F.lds + MISC_OFF);
    F.tid = threadIdx.x; F.lane = F.tid & 63; F.wave = __builtin_amdgcn_readfirstlane(F.tid >> 6);
    F.G = gridDim.x; { const int bx = blockIdx.x; F.vcu = (F.G % 8 == 0) ? (bx % 8) * (F.G / 8) + bx / 8 : bx; }
    F.ws = args.ws; F.out = args.out; F.ctl = (gu32*)(args.ws + WS_CTL);
    F.x_prompt = (const float*)args.in[0]; F.x_sample = (const float*)args.in[1]; F.cache_ckv = (const float*)args.in[2]; F.cache_kpe = (const float*)args.in[3]; F.state_conv = (const float*)args.in[4];
    F.page_table = (const int*)args.in[5]; F.meta = (const float*)args.in[6]; F.lne_g = (const float*)args.in[7]; F.lne_b = (const float*)args.in[8]; F.w_in = (const float*)args.in[9];
    F.qn_g = (const float*)args.in[10]; F.w_uq = (const float*)args.in[11]; F.kvn_g = (const float*)args.in[12]; F.w_uk = (const float*)args.in[13]; F.w_uv = (const float*)args.in[14];
    F.w_o_mla = (const float*)args.in[15]; F.conv_w = (const float*)args.in[16]; F.w_conv_out = (const float*)args.in[17]; F.w_o = (const float*)args.in[18]; F.ln1_g = (const float*)args.in[19];
    F.ln1_b = (const float*)args.in[20]; F.w_up = (const float*)args.in[21]; F.w_down = (const float*)args.in[22]; F.ln2_g = (const float*)args.in[23]; F.ln2_b = (const float*)args.in[24];
    for (int u = F.tid; u < (LDS_BYTES - LDSCTL_OFF) / 4; u += NWAVES * 64) ((LAS unsigned*)(F.lds + LDSCTL_OFF))[u] = 0u;
    __syncthreads();
    const int lo = args.ph_lo, hi = args.ph_hi;
    const bool one_phase = (hi - lo) == 1;
    XcdBarrier bar; bar.bar = (unsigned*)(F.ctl + CW_BAR); bar.x = 0; bar.st = nullptr;
    if (!one_phase) bar = xcd_barrier_post((unsigned*)(F.ctl + CW_BAR), F.MISC + 8);
#ifndef PH_MASK
#define PH_MASK 0xFFFFFFFFu
#endif
#define IN(k) ((((PH_MASK) >> (k)) & 1u) && lo <= (k) && (k) < hi)
#define SEAM(k) do { if (IN(k) && IN((k) + 1)) xcd_barrier(bar); } while (0)
    using pg8::bf16_t;
    if (IN(0)) { p0_prologue(F); SEAM(0); }
    if (IN(1)) {
        pg8::Gemm g{WSP(bf16_t, WS_XN), WSP(bf16_t, WS_WIN), M_ALL, NZ, D}; pg8::StaticOrder S; S.init(M_ALL, NZ, F.G, (int)blockIdx.x);
        epi::EpiZ E{WSP(float, WS_ZF), WSP(bf16_t, WS_GB), WSP(bf16_t, WS_U), WSP(bf16_t, WS_GCV), WSP(bf16_t, WS_GML), F.out + O_CONVP, F.out + O_CONVS};
        pg8::gemm_phase<epi::EpiZ, pg8::StaticOrder, true, true>(F.lds + RING_OFF, g, S, E);
        SEAM(1);
    }
    if (IN(2)) { p2_thin(F); SEAM(2); }
    if (IN(3)) {
#ifndef P3S
#define P3S 7
#endif
        if (P3S & 1) { pg8::Gemm g{WSP(bf16_t, WS_CQN), WSP(bf16_t, WS_WUQ), M_ALL, 768, QLORA}; pg8::StaticOrder S; S.init(M_ALL, 768, F.G, (int)blockIdx.x);
          epi::EpiQ E{WSP(bf16_t, WS_Q), WSP(float, WS_TAB)};
          pg8::gemm_phase<epi::EpiQ, pg8::StaticOrder, true, true>(F.lds + RING_OFF, g, S, E); }
        if (P3S & 2) { pg8::Gemm g{WSP(bf16_t, WS_CKV), WSP(bf16_t, WS_WKV), M_ALL, 1024, KVL}; pg8::StaticOrder S; S.init(M_ALL, 1024, F.G, (int)blockIdx.x);
          epi::EpiBf16S<1024> E{WSP(bf16_t, WS_KV), 1.0f};
          pg8::gemm_phase<epi::EpiBf16S<1024>, pg8::StaticOrder, true, true>(F.lds + RING_OFF, g, S, E); }
        if (P3S & 4) { pg8::Gemm g{WSP(bf16_t, WS_CQN) + (size_t)ROW_S * QLORA, WSP(bf16_t, WS_WABS), M_S, 2048, QLORA}; pg8::StaticOrder S; S.init(M_S, 2048, F.G, (int)blockIdx.x);
          epi::EpiBf16S<2048> E{WSP(bf16_t, WS_QLAT), QSCALE};
          pg8::gemm_phase<epi::EpiBf16S<2048>, pg8::StaticOrder, true, true>(F.lds + RING_OFF, g, S, E); }
        SEAM(3);
    }
    if (IN(4)) { pattn::prompt_phase(F.vcu, F.G, WSP(bf16, WS_Q), WSP(bf16, WS_KV), WSP(bf16, WS_KPE), WSP(bf16, WS_O), F.lds + RING_OFF);
        for (int uu = F.vcu; uu < DBATCH * 2; uu += F.G) dattn::decode_unit(uu >> 1, uu & 1, F.cache_ckv, F.cache_kpe, F.page_table, WSP(bf16, WS_Q), WSP(bf16, WS_QLAT), WSP(bf16, WS_CKV), WSP(bf16, WS_KPE), WSP(float, WS_PART), F.lds + RING_OFF);
        SEAM(4); }
    if (IN(5)) { decode_combine(F); SEAM(5); }
    if (IN(6)) {
        pg8::Gemm g{WSP(bf16_t, WS_CV), WSP(bf16_t, WS_WCO), M_ALL, D, CDIM}; pg8::StaticOrder S; S.init(M_ALL, D, F.G, (int)blockIdx.x);
        epi::EpiGateT E{WSP(bf16_t, WS_GCV), WSP(float, WS_T)};
        pg8::gemm_phase<epi::EpiGateT, pg8::StaticOrder, true, true>(F.lds + RING_OFF, g, S, E);
        SEAM(6);
    }
    if (IN(7)) {
        pg8::Gemm g{WSP(bf16_t, WS_O), WSP(bf16_t, WS_WOM), M_ALL, D, 512}; pg8::StaticOrder S; S.init(M_ALL, D, F.G, (int)blockIdx.x);
        epi::EpiMix E{WSP(bf16_t, WS_GML), WSP(float, WS_T), WSP(bf16_t, WS_MIXIN)};
        pg8::gemm_phase<epi::EpiMix, pg8::StaticOrder, true, true>(F.lds + RING_OFF, g, S, E);
        SEAM(7);
    }
    if (IN(8)) {
        pg8::Gemm g{WSP(bf16_t, WS_MIXIN), WSP(bf16_t, WS_WO), M_ALL, D, D}; pg8::StaticOrder S; S.init(M_ALL, D, F.G, (int)blockIdx.x);
        epi::EpiRes E{WSP(float, WS_H32), WSP(float, WS_R1)};
        pg8::gemm_phase<epi::EpiRes, pg8::StaticOrder, true, true>(F.lds + RING_OFF, g, S, E);
        SEAM(8);
    }
    if (IN(9)) { ln_pass(F, WSP(float, WS_R1), F.ln1_g, F.ln1_b, WSP(float, WS_H1), WSP(bf16, WS_H1N), ROW_M); SEAM(9); }
    if (IN(10)) {
        pg8::Gemm g{WSP(bf16_t, WS_H1N), WSP(bf16_t, WS_WUP), M_ALL, FF, D}; pg8::StaticOrder S; S.init(M_ALL, FF, F.G, (int)blockIdx.x);
        epi::EpiRelu2 E{WSP(bf16_t, WS_UP)};
        pg8::gemm_phase<epi::EpiRelu2, pg8::StaticOrder, true, true>(F.lds + RING_OFF, g, S, E);
        SEAM(10);
    }
    if (IN(11)) {
        pg8::Gemm g{WSP(bf16_t, WS_UP), WSP(bf16_t, WS_WDN), M_ALL, D, FF}; pg8::StaticOrder S; S.init(M_ALL, D, F.G, (int)blockIdx.x);
        epi::EpiRes E{WSP(float, WS_H1), WSP(float, WS_R2)};
        pg8::gemm_phase<epi::EpiRes, pg8::StaticOrder, true, true>(F.lds + RING_OFF, g, S, E);
        SEAM(11);
    }
    if (IN(12)) { ln_pass(F, WSP(float, WS_R2), F.ln2_g, F.ln2_b, F.out + O_YP, nullptr, ROW_M); }
#ifdef DBG_OFF
    {
        if (hi < NPHASE) xcd_barrier(bar);
        const bf16* B = WSP(bf16, DBG_OFF); const int gw = F.vcu * NWAVES + F.wave, NGW = F.G * NWAVES;
        for (int m = gw; m < ROW_M; m += NGW) for (int c = F.lane; c < D; c += 64) F.out[(size_t)m * D + c] = c < DBG_LD ? (DBG_C0 < 0 ? ((const float*)B)[(size_t)m * DBG_LD + c] : bf2f(B[(size_t)m * DBG_LD + c + (DBG_C0 < 0 ? 0 : DBG_C0)])) : 0.f;
    }
#endif
#undef IN
#undef SEAM
}

extern "C" void kernel_launch(void* const* d_in, const int* in_sizes, int n_in, void* d_out, int out_size, void* d_ws, size_t ws_size, hipStream_t stream) {
    static int grid = 0;
    if (grid == 0) {
        if (n_in != 25 || (size_t)out_size != O_END || ws_size < WS_END) { fprintf(stderr, "kernel_launch: unexpected shapes: n_in %d out %d ws %zu (need %zu)\n", n_in, out_size, ws_size, (size_t)WS_END); grid = -1; return; }
        int dev = 0, cus = 0, per_cu = 0;
        if (hipGetDevice(&dev) != hipSuccess || hipDeviceGetAttribute(&cus, hipDeviceAttributeMultiprocessorCount, dev) != hipSuccess) { grid = -1; return; }
        if (hipFuncSetAttribute((const void*)fwd_kernel, hipFuncAttributeMaxDynamicSharedMemorySize, LDS_BYTES) != hipSuccess) { fprintf(stderr, "kernel_launch: hipFuncSetAttribute failed\n"); grid = -1; return; }
        if (hipOccupancyMaxActiveBlocksPerMultiprocessor(&per_cu, (const void*)fwd_kernel, NWAVES * 64, LDS_BYTES) != hipSuccess || per_cu < 1)
            fprintf(stderr, "kernel_launch: note: occupancy query reports %d workgroups per CU\n", per_cu);
        (void)hipGetLastError();
        grid = cus;
    }
    if (grid < 0) return;
    if (hipMemsetAsync((char*)d_ws + WS_CTL, 0, CTL_ZERO_BYTES, stream) != hipSuccess) return;
    Args a{};
    for (int i = 0; i < 25; ++i) a.in[i] = d_in[i];
    a.out = (float*)d_out; a.ws = (unsigned char*)d_ws;
#if MK_N_LAUNCHES == 1
#ifndef PH_HI
#define PH_HI NPHASE
#endif
    a.ph_lo = 0; a.ph_hi = PH_HI;
    hipLaunchKernelGGL(fwd_kernel, dim3(grid), dim3(NWAVES * 64), LDS_BYTES, stream, a);
#else
    for (int p = 0; p < NPHASE; ++p) { a.ph_lo = p; a.ph_hi = p + 1; hipLaunchKernelGGL(fwd_kernel, dim3(grid), dim3(NWAVES * 64), LDS_BYTES, stream, a); }
#endif
}
```

```cpp
#include <hip/hip_runtime.h>
#include <cstdio>
#include <cstdint>
#include <cmath>
#define MK_N_LAUNCHES 1
constexpr int D = 1024, NB = 16, SEQ = 2048, NMETA = 16, LP = SEQ + NMETA;
constexpr int DBATCH = 128, DSEQ = 8, PAST = 8192, PAGE = 128, NPG = PAST / PAGE;
constexpr int NH = 8, QLORA = 384, KVL = 256, NOPE = 64, ROPE = 32, QHD = NOPE + ROPE, VHD = 64;
constexpr int CDIM = 512, FF = 4096, DIN = 4256;
constexpr int M_P = NB * SEQ;
constexpr int M_S = DBATCH * DSEQ;
constexpr int ROW_S = M_P, ROW_M = M_P + M_S;
constexpr int M_ALL = ROW_M + 256;
constexpr int NZ = 4352;
constexpr int NTAB = LP + DSEQ;
constexpr float LN_EPS = 1e-5f, RMS_EPS = 1e-6f;
constexpr float ALPHA = 1.189207115002721f;
constexpr float QSCALE = 0.10206207261596577f * 1.4426950408889634f;
constexpr int NSPLIT = 4;

constexpr int ZC_CQ = 0, ZC_CKV = 384, ZC_KPE = 640, ZC_GB = 672, ZC_GC = 1184, ZC_CH = 1696, ZC_GCV = 2208, ZC_GML = 3232;

constexpr size_t O_YP = 0, O_YS = O_YP + (size_t)M_P * D, O_CKVP = O_YS + (size_t)M_S * D, O_KPEP = O_CKVP + (size_t)NB * LP * KVL,
                 O_CONVP = O_KPEP + (size_t)NB * LP * ROPE, O_CKVS = O_CONVP + (size_t)NB * 2 * CDIM, O_KPES = O_CKVS + (size_t)M_S * KVL,
                 O_CONVS = O_KPES + (size_t)M_S * ROPE, O_END = O_CONVS + (size_t)DBATCH * 2 * CDIM;

constexpr size_t MiB = 1u << 20;
constexpr size_t al(size_t x) { return (x + MiB - 1) / MiB * MiB; }
constexpr size_t WS_CTL = 0, CTL_ZERO_BYTES = 1 * MiB;
constexpr size_t WS_WIN = 1 * MiB;
constexpr size_t WS_WUQ = WS_WIN + al((size_t)NZ * D * 2);
constexpr size_t WS_WABS = WS_WUQ + al((size_t)768 * QLORA * 2);
constexpr size_t WS_WKV = WS_WABS + al((size_t)2048 * QLORA * 2);
constexpr size_t WS_WCO = WS_WKV + al((size_t)1024 * KVL * 2);
constexpr size_t WS_WOM = WS_WCO + al((size_t)D * CDIM * 2);
constexpr size_t WS_WO = WS_WOM + al((size_t)D * 512 * 2);
constexpr size_t WS_WUP = WS_WO + al((size_t)D * D * 2);
constexpr size_t WS_WDN = WS_WUP + al((size_t)FF * D * 2);
constexpr size_t WS_TAB = WS_WDN + al((size_t)D * FF * 2);
constexpr size_t WS_XN = WS_TAB + al((size_t)NTAB * 32 * 4);
constexpr size_t WS_H32 = WS_XN + al((size_t)M_ALL * D * 2);
constexpr size_t WS_ZF = WS_H32 + al((size_t)M_ALL * D * 4);
constexpr size_t WS_GB = WS_ZF + al((size_t)M_ALL * 768 * 4);
constexpr size_t WS_U = WS_GB + al((size_t)M_ALL * 512 * 2);
constexpr size_t WS_GCV = WS_U + al((size_t)M_ALL * 512 * 2);
constexpr size_t WS_GML = WS_GCV + al((size_t)M_ALL * D * 2);
constexpr size_t WS_CQN = WS_GML + al((size_t)M_ALL * D * 2);
constexpr size_t WS_CKV = WS_CQN + al((size_t)M_ALL * QLORA * 2);
constexpr size_t WS_KPE = WS_CKV + al((size_t)M_ALL * KVL * 2);
constexpr size_t WS_CV = WS_KPE + al((size_t)M_ALL * ROPE * 2);
constexpr size_t WS_Q = WS_CV + al((size_t)M_ALL * CDIM * 2);
constexpr size_t WS_KV = WS_Q + al((size_t)M_ALL * 768 * 2);
constexpr size_t WS_QLAT = WS_KV + al((size_t)M_ALL * 1024 * 2);
constexpr size_t WS_O = WS_QLAT + al((size_t)M_S * 2048 * 2);
constexpr size_t WS_PART = WS_O + al((size_t)M_ALL * 512 * 2);
constexpr size_t WS_T = WS_PART + al((size_t)DBATCH * NSPLIT * 64 * 264 * 4);
constexpr size_t WS_MIXIN = WS_T + al((size_t)M_ALL * D * 4);
constexpr size_t WS_R1 = WS_MIXIN + al((size_t)M_ALL * D * 2);
constexpr size_t WS_H1 = WS_R1 + al((size_t)M_ALL * D * 4);
constexpr size_t WS_H1N = WS_H1 + al((size_t)M_ALL * D * 4);
constexpr size_t WS_UP = WS_H1N + al((size_t)M_ALL * D * 2);
constexpr size_t WS_R2 = WS_UP + al((size_t)M_ALL * FF * 2);
constexpr size_t WS_END = WS_R2 + al((size_t)M_ALL * D * 4);
constexpr int CW_TMO = 0, CW_CODE = 1, CW_BAR = 4096;

constexpr int RING_OFF = 0, RING_BYTES = 131072;
constexpr int LDSCTL_OFF = RING_BYTES, MISC_OFF = LDSCTL_OFF + 320;
constexpr int LDS_BYTES = 147456;
constexpr int NWAVES = 8;
namespace pg8 {
#define PG8_LAS __attribute__((address_space(3)))
typedef unsigned short bf16_t;
typedef short bf16x8 __attribute__((ext_vector_type(8)));
typedef float f32x4 __attribute__((ext_vector_type(4)));
typedef unsigned u32x4 __attribute__((ext_vector_type(4)));
constexpr int BM = 256, BK = 64, HALF = 128, HTB = HALF * BK * 2  , STAGE_BYTES = 8 * HTB, NXCD = 8, WGM = 8;

__host__ __device__ __forceinline__ int lds_byte(int r, int c) { const int st = (r >> 4) * 2 + (c >> 5), rr = r & 15, cc = c & 31, ob = rr * 64 + cc * 2; return st * 1024 + (ob ^ (((ob >> 9) & 1) << 5)); }
__host__ __device__ __forceinline__ void stage_rc(int b, int& R, int& C) { const int st = b / 1024, sb = b % 1024, swz = sb ^ (((sb >> 9) & 1) << 5); R = (st >> 1) * 16 + swz / 64; C = (st & 1) * 32 + (swz % 64) / 2; }
__host__ __device__ __forceinline__ int perm32(int rho) { const int n = rho >> 4, i = rho & 15; return 8 * (i >> 2) + 4 * n + (i & 3); }

struct Unit { int pm, pn; };
struct Gemm { const bf16_t* A; const bf16_t* Bt; int M, N, K; };

struct StaticOrder {
    int nM, nN, nwg, G, c;
    __host__ __device__ void init(int M, int N, int G_, int c_) { nM = M / BM; nN = N / BM; nwg = nM * nN; G = G_; c = c_; }
    __host__ __device__ bool next(int i, Unit& u) const {
        const long L = (long)i * G + c; if (L >= nwg) return false;
        int wgid = (int)L; { const int q = nwg / NXCD, r = nwg % NXCD, xcd = wgid % NXCD, off = wgid / NXCD; wgid = (xcd < r ? xcd * (q + 1) : r * (q + 1) + (xcd - r) * q) + off; }
        const int nig = WGM * nN, gid = wgid / nig, fm = gid * WGM, gsz = (nM - fm) < WGM ? (nM - fm) : WGM;
        u.pm = fm + ((wgid % nig) % gsz); u.pn = (wgid % nig) / gsz; return true;
    }
    __device__ __forceinline__ void a_ready(const Unit&) const {}
    __device__ __forceinline__ void done(const Unit&) const {}
};

__device__ __forceinline__ unsigned cvt_pk_bf16(float lo, float hi) { unsigned r; asm volatile("v_cvt_pk_bf16_f32 %0, %1, %2" : "=v"(r) : "v"(lo), "v"(hi)); return r; }
typedef float f32x2 __attribute__((ext_vector_type(2)));
template <class Epi, class Sched, bool ALIGN_EPI = false, bool SP2 = false>
__device__ __forceinline__ void gemm_phase(PG8_LAS unsigned char* lds, const Gemm g, const Sched& S, const Epi& E) {
    const int tid = threadIdx.x, wid = __builtin_amdgcn_readfirstlane(tid >> 6), lane = tid & 63, wr = wid >> 2, wc = wid & 3, fr = lane & 15, fq = lane >> 4;
    const int K = g.K, nt = K / BK;
    unsigned voffA[2], voffB[2];
#pragma unroll
    for (int i = 0; i < 2; ++i) { int R, C; stage_rc(tid * 16 + i * 8192, R, C); const int Rb = Epi::PERM ? ((R & ~31) + perm32(R & 31)) : R;
        voffA[i] = (unsigned)(R * K + C) * 2u; voffB[i] = (unsigned)(Rb * K + C) * 2u; }
    const size_t kstep = (size_t)(BK * 2);
    const size_t hstep = (size_t)HALF * K * 2;
    const size_t tstep = 2 * hstep;
    const unsigned ldsw = (unsigned)wid * 1024u;
    const int aoff = lds_byte(wr * 64 + fr, fq * 8), boff = lds_byte(wc * 32 + fr, fq * 8);
#define PG8_SA(b, h) (((b) * 2 + (h)) * HTB)
#define PG8_SB(b, h) ((4 + (b) * 2 + (h)) * HTB)
#define PG8_STAGE(bufoff, gbase, voff) do { _Pragma("unroll") for (int _i = 0; _i < 2; ++_i) \
        __builtin_amdgcn_global_load_lds((const unsigned*)((const char*)(gbase) + (voff)[_i]), (PG8_LAS unsigned*)(lds + (bufoff) + ldsw + _i * 8192), 16, 0, 0); } while (0)
#define PG8_LDA(dst, b, h) do { _Pragma("unroll") for (int m = 0; m < 4; ++m) _Pragma("unroll") for (int k = 0; k < 2; ++k) dst[m][k] = *(const PG8_LAS bf16x8*)(lds + PG8_SA(b, h) + aoff + m * 2048 + k * 1024); } while (0)
#define PG8_LDB(dst, b, h) do { _Pragma("unroll") for (int n = 0; n < 2; ++n) _Pragma("unroll") for (int k = 0; k < 2; ++k) dst[n][k] = *(const PG8_LAS bf16x8*)(lds + PG8_SB(b, h) + boff + n * 2048 + k * 1024); } while (0)
#define PG8_MMA(ai, bj, At, Bt) do { __builtin_amdgcn_s_setprio(1); _Pragma("unroll") for (int m = 0; m < 4; ++m) _Pragma("unroll") for (int n = 0; n < 2; ++n) _Pragma("unroll") for (int k = 0; k < 2; ++k) \
        acc[ai][bj][m][n] = __builtin_amdgcn_mfma_f32_16x16x32_bf16(Bt[n][k], At[m][k], acc[ai][bj][m][n], 0, 0, 0); __builtin_amdgcn_s_setprio(0); } while (0)
#define PG8_WAIT_V(n) asm volatile("s_waitcnt vmcnt(" #n ")" ::: "memory")
#define PG8_WAIT_L(n) asm volatile("s_waitcnt lgkmcnt(" #n ")" ::: "memory")
#define PG8_BAR __builtin_amdgcn_s_barrier()
#define PG8_SCHED __builtin_amdgcn_sched_barrier(0)
    Unit cur, nxt; int ui = 0;
    if (!S.next(0, cur)) return;
    f32x4 acc[2][2][4][2];
#pragma unroll
    for (int a = 0; a < 2; ++a)
#pragma unroll
        for (int b = 0; b < 2; ++b)
#pragma unroll
            for (int m = 0; m < 4; ++m)
#pragma unroll
                for (int n = 0; n < 2; ++n) acc[a][b][m][n] = (f32x4){0.f, 0.f, 0.f, 0.f};
    bf16x8 At[4][2], B0[2][2], B1[2][2];
    const char* cA = (const char*)g.A + (size_t)cur.pm * tstep; const char* cB = (const char*)g.Bt + (size_t)cur.pn * tstep;
    S.a_ready(cur);
    if constexpr (SP2) {
        PG8_STAGE(PG8_SB(0, 0), cB, voffB); PG8_STAGE(PG8_SB(0, 1), cB + hstep, voffB); PG8_STAGE(PG8_SA(0, 0), cA, voffA); PG8_STAGE(PG8_SA(0, 1), cA + hstep, voffA);
        if (wr == 1) PG8_BAR;
        PG8_WAIT_V(2); PG8_BAR;
        PG8_STAGE(PG8_SB(1, 0), cB + kstep, voffB); PG8_STAGE(PG8_SA(1, 0), cA + kstep, voffA); PG8_STAGE(PG8_SB(1, 1), cB + hstep + kstep, voffB);
        PG8_WAIT_V(6); PG8_BAR;
    } else {
        PG8_STAGE(PG8_SB(0, 0), cB, voffB); PG8_STAGE(PG8_SA(0, 0), cA, voffA); PG8_STAGE(PG8_SB(0, 1), cB + hstep, voffB); PG8_STAGE(PG8_SA(0, 1), cA + hstep, voffA);
        if (wr == 1) PG8_BAR;
        PG8_WAIT_V(4); PG8_BAR;
        PG8_STAGE(PG8_SB(1, 0), cB + kstep, voffB); PG8_STAGE(PG8_SA(1, 0), cA + kstep, voffA); PG8_STAGE(PG8_SB(1, 1), cB + hstep + kstep, voffB);
        PG8_WAIT_V(6); PG8_BAR;
    }
    for (;;) {
        const bool has_next = S.next(ui + 1, nxt);
        const char* nA = has_next ? (const char*)g.A + (size_t)nxt.pm * tstep : cA; const char* nB = has_next ? (const char*)g.Bt + (size_t)nxt.pn * tstep : cB;
#pragma unroll 1
        for (int t = 0; t < nt; t += 2) {
            const bool last = (t == nt - 2);
            const char* a1 = cA + (size_t)(t + 1) * kstep;
            const char* a2 = last ? nA : cA + (size_t)(t + 2) * kstep; const char* b2 = last ? nB : cB + (size_t)(t + 2) * kstep;
            const char* a3 = a2 + kstep; const char* b3 = b2 + kstep;
            if (last && has_next) S.a_ready(nxt);
            if constexpr (SP2) {
            PG8_LDB(B0, 0, 0); PG8_LDB(B1, 0, 1); PG8_SCHED; PG8_LDA(At, 0, 0); PG8_STAGE(PG8_SA(1, 1), a1 + hstep, voffA);
            PG8_WAIT_V(8); PG8_WAIT_L(0); PG8_BAR; PG8_MMA(0, 0, At, B0); PG8_MMA(0, 1, At, B1); PG8_BAR; PG8_SCHED;
            PG8_LDA(At, 0, 1); PG8_STAGE(PG8_SB(0, 0), b2, voffB); PG8_STAGE(PG8_SB(0, 1), b2 + hstep, voffB); PG8_STAGE(PG8_SA(0, 0), a2, voffA);
            PG8_WAIT_V(8); PG8_WAIT_L(0); PG8_BAR; PG8_MMA(1, 0, At, B0); PG8_MMA(1, 1, At, B1); PG8_BAR; PG8_SCHED;
            PG8_LDB(B0, 1, 0); PG8_LDB(B1, 1, 1); PG8_SCHED; PG8_LDA(At, 1, 0); PG8_STAGE(PG8_SA(0, 1), a2 + hstep, voffA);
            PG8_WAIT_V(8); PG8_WAIT_L(0); PG8_BAR; PG8_MMA(0, 0, At, B0); PG8_MMA(0, 1, At, B1); PG8_BAR; PG8_SCHED;
            PG8_LDA(At, 1, 1); PG8_STAGE(PG8_SB(1, 0), b3, voffB); PG8_STAGE(PG8_SB(1, 1), b3 + hstep, voffB); PG8_STAGE(PG8_SA(1, 0), a3, voffA);
            PG8_WAIT_V(8); PG8_WAIT_L(0); PG8_BAR; PG8_MMA(1, 0, At, B0); PG8_MMA(1, 1, At, B1); PG8_BAR; PG8_SCHED;
            } else {
            PG8_LDB(B0, 0, 0); PG8_SCHED; PG8_LDA(At, 0, 0); PG8_STAGE(PG8_SA(1, 1), a1 + hstep, voffA);
            PG8_WAIT_L(8); PG8_BAR; PG8_WAIT_L(0); PG8_MMA(0, 0, At, B0); PG8_BAR; PG8_SCHED;
            PG8_LDB(B1, 0, 1); PG8_STAGE(PG8_SB(0, 0), b2, voffB);
            PG8_BAR; PG8_WAIT_L(0); PG8_MMA(0, 1, At, B1); PG8_BAR;
            PG8_LDA(At, 0, 1); PG8_STAGE(PG8_SA(0, 0), a2, voffA);
            PG8_BAR; PG8_WAIT_L(0); PG8_MMA(1, 0, At, B0); PG8_BAR; PG8_SCHED;
            PG8_STAGE(PG8_SB(0, 1), b2 + hstep, voffB);
            PG8_WAIT_V(6); PG8_BAR; PG8_MMA(1, 1, At, B1); PG8_BAR;
            PG8_LDB(B0, 1, 0); PG8_SCHED; PG8_LDA(At, 1, 0); PG8_STAGE(PG8_SA(0, 1), a2 + hstep, voffA);
            PG8_WAIT_L(8); PG8_BAR; PG8_WAIT_L(0); PG8_MMA(0, 0, At, B0); PG8_BAR; PG8_SCHED;
            PG8_LDB(B1, 1, 1); PG8_STAGE(PG8_SB(1, 0), b3, voffB);
            PG8_BAR; PG8_WAIT_L(0); PG8_MMA(0, 1, At, B1); PG8_BAR;
            PG8_LDA(At, 1, 1); PG8_STAGE(PG8_SA(1, 0), a3, voffA);
            PG8_BAR; PG8_WAIT_L(0); PG8_MMA(1, 0, At, B0); PG8_BAR; PG8_SCHED;
            PG8_STAGE(PG8_SB(1, 1), b3 + hstep, voffB);
            PG8_WAIT_V(6); PG8_BAR; PG8_MMA(1, 1, At, B1); PG8_BAR;
            }
        }
        if constexpr (ALIGN_EPI) { if (wr == 0) PG8_BAR; }
        if constexpr (!Epi::AFTER_DRAIN) { E(acc, cur, wr, wc, fr, fq); S.done(cur); }
        if (!has_next) break;
#pragma unroll
        for (int a = 0; a < 2; ++a)
#pragma unroll
            for (int b = 0; b < 2; ++b)
#pragma unroll
                for (int m = 0; m < 4; ++m)
#pragma unroll
                    for (int n = 0; n < 2; ++n) acc[a][b][m][n] = (f32x4){0.f, 0.f, 0.f, 0.f};
        cur = nxt; cA = nA; cB = nB; ++ui;
        if constexpr (ALIGN_EPI) { if (wr == 1) PG8_BAR; }
    }
    PG8_WAIT_V(0);
    if constexpr (!ALIGN_EPI) { if (wr == 0) PG8_BAR; }
    PG8_BAR;
    if constexpr (Epi::AFTER_DRAIN) { E.fused(acc, cur, wr, wc, fr, fq, lds, wid, lane); S.done(cur); }
#undef PG8_SA
#undef PG8_SB
#undef PG8_STAGE
#undef PG8_LDA
#undef PG8_LDB
#undef PG8_MMA
#undef PG8_WAIT_V
#undef PG8_WAIT_L
#undef PG8_BAR
#undef PG8_SCHED
}
}
#define GAS __attribute__((address_space(1)))
#define LAS __attribute__((address_space(3)))
typedef unsigned short bf16;
typedef unsigned v4u __attribute__((ext_vector_type(4)));
typedef float f32x4 __attribute__((ext_vector_type(4)));
typedef short bf16x8 __attribute__((ext_vector_type(8)));
typedef GAS unsigned gu32;
typedef GAS unsigned long long gu64;
#define RLX_AGENT __ATOMIC_RELAXED, __HIP_MEMORY_SCOPE_AGENT
#define LDS_WAIT() asm volatile("s_waitcnt lgkmcnt(0)" ::: "memory")
#define VM_WAIT() asm volatile("s_waitcnt vmcnt(0)" ::: "memory")
__device__ __forceinline__ unsigned long long rt() { return __builtin_amdgcn_s_memrealtime(); }
__device__ __forceinline__ unsigned f2bf(float f) { unsigned u = __builtin_bit_cast(unsigned, f); return (u + 0x7fffu + ((u >> 16) & 1u)) >> 16; }
__device__ __forceinline__ unsigned pk2(float lo, float hi) { return f2bf(lo) | (f2bf(hi) << 16); }

#define XB_TMO      128
#define XB_XCNT(j)  (256  + 64 * (j))
#define XB_XSUB(j)  (1280 + 64 * (j))
#define XB_XGEN(j)  (2304 + 64 * (j))
#define XB_TOP      3328
#define XB_TOPGEN   3392
#define XCD_BAR_WORDS 3456
#define XB_SPIN_CAP (1u << 18)

__device__ __forceinline__ unsigned xb_ld(unsigned* p)              { return __hip_atomic_load(p, __ATOMIC_RELAXED, __HIP_MEMORY_SCOPE_AGENT); }
__device__ __forceinline__ unsigned xb_add(unsigned* p, unsigned v) { return __hip_atomic_fetch_add(p, v, __ATOMIC_RELAXED, __HIP_MEMORY_SCOPE_AGENT); }
__device__ __forceinline__ unsigned xb_xcc_id() { return (unsigned)__builtin_amdgcn_s_getreg((3 << 11) | 20) & 0xFu; }
#define XB_SPIN(cond, bar) do { unsigned _sp = 0; while (cond) { __builtin_amdgcn_s_sleep(1); \
    if ((++_sp & 255u) == 0u) { if (xb_ld(&(bar)[XB_TMO])) break; if (_sp > XB_SPIN_CAP) { atomicAdd(&(bar)[XB_TMO], 1u); break; } } } } while (0)

struct XcdBarrier {
    unsigned* bar; unsigned x;
    volatile LAS unsigned* st;
};

__device__ __forceinline__ XcdBarrier xcd_barrier_post(unsigned* bar, volatile LAS unsigned* st) {
    XcdBarrier b; b.bar = bar; b.x = xb_xcc_id(); b.st = st;
    if (threadIdx.x == 0) (void)xb_add(&bar[XB_XCNT(b.x)], 1u);
    return b;
}
__device__ __forceinline__ void xcd_barrier_complete(unsigned* bar, unsigned x, unsigned& nloc, unsigned& nx) {
    const unsigned G = gridDim.x * gridDim.y * gridDim.z;
    unsigned sum, cnt, mine, sp = 0u;
    for (;;) {
        sum = 0u; cnt = 0u; mine = 0u;
#pragma unroll
        for (unsigned j = 0; j < 16; ++j) { const unsigned c = xb_ld(&bar[XB_XCNT(j)]); sum += c; cnt += (c > 0u) ? 1u : 0u; mine = (j == x) ? c : mine; }
        if (sum == G) break;
        __builtin_amdgcn_s_sleep(1);
        if ((++sp & 255u) == 0u) { if (xb_ld(&bar[XB_TMO])) break; if (sp > XB_SPIN_CAP) { atomicAdd(&bar[XB_TMO], 1u); break; } }
    }
    nloc = mine > 0u ? mine : 1u; nx = cnt > 0u ? cnt : 1u;
}

__device__ __forceinline__ void xcd_barrier(const XcdBarrier& b) {
    asm volatile("s_waitcnt vmcnt(0)" ::: "memory");
    __syncthreads();
    if (threadIdx.x == 0) {
        unsigned* bar = b.bar;
        __builtin_amdgcn_s_waitcnt(0);
        unsigned nloc = b.st[0], nx = b.st[1];
        if (nloc == 0u) { xcd_barrier_complete(bar, b.x, nloc, nx); b.st[0] = nloc; b.st[1] = nx; }
        const unsigned old = xb_add(&bar[XB_XSUB(b.x)], 1u);
        const unsigned gen = old / nloc;
        if (old + 1u == (gen + 1u) * nloc) {
            __builtin_amdgcn_fence(__ATOMIC_RELEASE, "agent");
            asm volatile("s_waitcnt vmcnt(0)" ::: "memory");
            const unsigned og = xb_add(&bar[XB_TOP], 1u);
            const unsigned tg = og / nx;
            if (og + 1u == (tg + 1u) * nx) xb_add(&bar[XB_TOPGEN], 1u);
            else XB_SPIN(xb_ld(&bar[XB_TOPGEN]) == tg, bar);
            __builtin_amdgcn_fence(__ATOMIC_ACQUIRE, "agent");
            xb_add(&bar[XB_XGEN(b.x)], 1u);
            asm volatile("s_waitcnt vmcnt(0)" ::: "memory");
        } else {
            XB_SPIN(xb_ld(&bar[XB_XGEN(b.x)]) == gen, bar);
            __builtin_amdgcn_fence(__ATOMIC_ACQUIRE, "agent");
            asm volatile("s_waitcnt vmcnt(0)" ::: "memory");
        }
    }
    __syncthreads();
}
namespace epi {
using pg8::f32x4; using pg8::u32x4; using pg8::bf16_t; using pg8::Unit;
typedef float f32x2_t __attribute__((ext_vector_type(2))); typedef __bf16 bf16x2_t __attribute__((ext_vector_type(2)));
__device__ __forceinline__ unsigned cvt_pk_bf16(float lo, float hi) { f32x2_t v = {lo, hi}; bf16x2_t b = __builtin_convertvector(v, bf16x2_t); return __builtin_bit_cast(unsigned, b); }
typedef unsigned u32x2 __attribute__((ext_vector_type(2)));
typedef const f32x4 (&Acc)[2][2][4][2];
__device__ __forceinline__ u32x4 pack8(f32x4 a, f32x4 b) { u32x4 w; w.x = cvt_pk_bf16(a[0], a[1]); w.y = cvt_pk_bf16(a[2], a[3]); w.z = cvt_pk_bf16(b[0], b[1]); w.w = cvt_pk_bf16(b[2], b[3]); return w; }
__device__ __forceinline__ f32x4 unpack_lo(unsigned a, unsigned b) { return (f32x4){__uint_as_float(a << 16), __uint_as_float(a & 0xffff0000u), __uint_as_float(b << 16), __uint_as_float(b & 0xffff0000u)}; }
__device__ __forceinline__ float sigmoidf_(float x) { return __builtin_amdgcn_rcpf(1.0f + __builtin_amdgcn_exp2f(-1.4426950408889634f * x)); }
__device__ __forceinline__ f32x4 sig4(f32x4 v) { return (f32x4){sigmoidf_(v[0]), sigmoidf_(v[1]), sigmoidf_(v[2]), sigmoidf_(v[3])}; }
__device__ __forceinline__ int tab_pos(int row) { return row < M_P ? NMETA + (row & (SEQ - 1)) : (row < ROW_M ? LP + ((row - ROW_S) & (DSEQ - 1)) : (row - ROW_M < NMETA ? row - ROW_M : NMETA - 1)); }

struct EpiZ {
    static constexpr bool PERM = true, AFTER_DRAIN = false;
    float* ZF; bf16_t* GB; bf16_t* U; bf16_t* GCV; bf16_t* GML; float* conv_p; float* conv_s;
    __device__ __forceinline__ void operator()(Acc acc, const Unit& u, int wr, int wc, int fr, int fq) const {
        const int pn = u.pn, row0 = u.pm * 256 + wr * 64 + fr, cl = wc * 32 + 8 * fq;
        if (pn < 3) {
#pragma unroll
            for (int ai = 0; ai < 2; ++ai)
#pragma unroll
                for (int m = 0; m < 4; ++m) { float* rp = ZF + (size_t)(row0 + ai * 128 + m * 16) * 768 + pn * 256 + cl;
#pragma unroll
                    for (int bj = 0; bj < 2; ++bj) { *(f32x4*)(rp + bj * 128) = acc[ai][bj][m][0]; *(f32x4*)(rp + bj * 128 + 4) = acc[ai][bj][m][1]; } }
        } else if (pn < 5) {
#pragma unroll
            for (int ai = 0; ai < 2; ++ai)
#pragma unroll
                for (int m = 0; m < 4; ++m) { bf16_t* rp = GB + (size_t)(row0 + ai * 128 + m * 16) * CDIM + (pn - 3) * 256 + cl;
#pragma unroll
                    for (int bj = 0; bj < 2; ++bj) *(u32x4*)(rp + bj * 128) = pack8(acc[ai][bj][m][0], acc[ai][bj][m][1]); }
        } else if (pn < 9) {
            const int cu = (pn - 5) * 128 + cl;
#pragma unroll
            for (int ai = 0; ai < 2; ++ai)
#pragma unroll
                for (int m = 0; m < 4; ++m) { const int row = row0 + ai * 128 + m * 16;
                    const f32x4 u0 = acc[ai][0][m][0] * acc[ai][1][m][0], u1 = acc[ai][0][m][1] * acc[ai][1][m][1];
                    *(u32x4*)(U + (size_t)row * CDIM + cu) = pack8(u0, u1);
                    if (row < M_P) { const int t = row & (SEQ - 1); if (t >= SEQ - 2) { float* o = conv_p + ((size_t)(row >> 11) * 2 + (t - (SEQ - 2))) * CDIM + cu; *(f32x4*)o = u0; *(f32x4*)(o + 4) = u1; } }
                    else if (row < ROW_M) { const int j = (row - ROW_S) & 7; if (j >= 6) { float* o = conv_s + ((size_t)((row - ROW_S) >> 3) * 2 + (j - 6)) * CDIM + cu; *(f32x4*)o = u0; *(f32x4*)(o + 4) = u1; } } }
        } else {
            bf16_t* base = (pn < 13 ? GCV + (pn - 9) * 256 : GML + (pn - 13) * 256) + cl;
#pragma unroll
            for (int ai = 0; ai < 2; ++ai)
#pragma unroll
                for (int m = 0; m < 4; ++m) { bf16_t* rp = base + (size_t)(row0 + ai * 128 + m * 16) * D;
#pragma unroll
                    for (int bj = 0; bj < 2; ++bj) *(u32x4*)(rp + bj * 128) = pack8(sig4(acc[ai][bj][m][0]), sig4(acc[ai][bj][m][1])); }
        }
    }
};
struct EpiQ {
    static constexpr bool PERM = false, AFTER_DRAIN = false;
    bf16_t* Q; const float* tab;
    __device__ __forceinline__ void operator()(Acc acc, const Unit& u, int wr, int wc, int fr, int fq) const {
        const int row0 = u.pm * 256 + wr * 64 + fr;
        const int G0 = u.pn * 8 + wc, G1 = G0 + 4; const bool pe0 = (G0 % 3) == 2, pe1 = (G1 % 3) == 2;
#pragma unroll
        for (int ai = 0; ai < 2; ++ai)
#pragma unroll
            for (int m = 0; m < 4; ++m) { const int row = row0 + ai * 128 + m * 16; bf16_t* rp = Q + (size_t)row * 768 + 4 * fq;
                f32x4 cs = (f32x4){1.f, 1.f, 1.f, 1.f}, sn = (f32x4){0.f, 0.f, 0.f, 0.f};
                if (pe0 || pe1) { const float* tp = tab + (size_t)tab_pos(row) * 32 + 4 * fq; cs = *(const f32x4*)tp; sn = *(const f32x4*)(tp + 16); }
#pragma unroll
                for (int bj = 0; bj < 2; ++bj) { f32x4 a = acc[ai][bj][m][0], b = acc[ai][bj][m][1];
                    if (bj == 0 ? pe0 : pe1) { const f32x4 y1 = a * cs - b * sn, y2 = b * cs + a * sn; a = y1; b = y2; }
                    a = a * QSCALE; b = b * QSCALE;
                    u32x2 w0, w1; w0.x = cvt_pk_bf16(a[0], a[1]); w0.y = cvt_pk_bf16(a[2], a[3]); w1.x = cvt_pk_bf16(b[0], b[1]); w1.y = cvt_pk_bf16(b[2], b[3]);
                    bf16_t* cp = rp + (bj == 0 ? G0 : G1) * 32; *(u32x2*)cp = w0; *(u32x2*)(cp + 16) = w1; }
                asm volatile("" ::: "memory"); }
    }
};
template <int ldc> struct EpiBf16S {
    static constexpr bool PERM = true, AFTER_DRAIN = false;
    bf16_t* O; float s;
    __device__ __forceinline__ void operator()(Acc acc, const Unit& u, int wr, int wc, int fr, int fq) const {
        const int row0 = u.pm * 256 + wr * 64 + fr, col0 = u.pn * 256 + wc * 32 + 8 * fq;
#pragma unroll
        for (int ai = 0; ai < 2; ++ai)
#pragma unroll
            for (int m = 0; m < 4; ++m) { bf16_t* rp = O + (size_t)(row0 + ai * 128 + m * 16) * ldc + col0;
#pragma unroll
                for (int bj = 0; bj < 2; ++bj) *(u32x4*)(rp + bj * 128) = pack8(acc[ai][bj][m][0] * s, acc[ai][bj][m][1] * s); }
    }
};
struct EpiGateT {
    static constexpr bool PERM = true, AFTER_DRAIN = false;
    const bf16_t* G; bf16_t* T;
    __device__ __forceinline__ void operator()(Acc acc, const Unit& u, int wr, int wc, int fr, int fq) const {
        const int row0 = u.pm * 256 + wr * 64 + fr, col0 = u.pn * 256 + wc * 32 + 8 * fq;
#pragma unroll
        for (int ai = 0; ai < 2; ++ai)
#pragma unroll
            for (int m = 0; m < 4; ++m) { const size_t off = (size_t)(row0 + ai * 128 + m * 16) * D + col0;
#pragma unroll
                for (int bj = 0; bj < 2; ++bj) { const u32x4 g = *(const u32x4*)(G + off + bj * 128);
                    *(u32x4*)(T + off + bj * 128) = pack8(unpack_lo(g.x, g.y) * acc[ai][bj][m][0], unpack_lo(g.z, g.w) * acc[ai][bj][m][1]); } }
    }
};
struct EpiMix {
    static constexpr bool PERM = true, AFTER_DRAIN = false;
    const bf16_t* G; const bf16_t* T; bf16_t* O;
    __device__ __forceinline__ void operator()(Acc acc, const Unit& u, int wr, int wc, int fr, int fq) const {
        const int row0 = u.pm * 256 + wr * 64 + fr, col0 = u.pn * 256 + wc * 32 + 8 * fq;
#pragma unroll
        for (int ai = 0; ai < 2; ++ai)
#pragma unroll
            for (int m = 0; m < 4; ++m) { const size_t off = (size_t)(row0 + ai * 128 + m * 16) * D + col0;
#pragma unroll
                for (int bj = 0; bj < 2; ++bj) { const u32x4 g = *(const u32x4*)(G + off + bj * 128), t = *(const u32x4*)(T + off + bj * 128);
                    *(u32x4*)(O + off + bj * 128) = pack8(unpack_lo(t.x, t.y) + unpack_lo(g.x, g.y) * acc[ai][bj][m][0], unpack_lo(t.z, t.w) + unpack_lo(g.z, g.w) * acc[ai][bj][m][1]); } }
    }
};
struct EpiRes {
    static constexpr bool PERM = true, AFTER_DRAIN = false;
    const bf16_t* res; float* R;
    __device__ __forceinline__ void operator()(Acc acc, const Unit& u, int wr, int wc, int fr, int fq) const {
        const int row0 = u.pm * 256 + wr * 64 + fr, col0 = u.pn * 256 + wc * 32 + 8 * fq;
#pragma unroll
        for (int ai = 0; ai < 2; ++ai)
#pragma unroll
            for (int m = 0; m < 4; ++m) { const size_t off = (size_t)(row0 + ai * 128 + m * 16) * D + col0;
#pragma unroll
                for (int bj = 0; bj < 2; ++bj) { const u32x4 r = *(const u32x4*)(res + off + bj * 128);
                    *(f32x4*)(R + off + bj * 128) = unpack_lo(r.x, r.y) * ALPHA + acc[ai][bj][m][0]; *(f32x4*)(R + off + bj * 128 + 4) = unpack_lo(r.z, r.w) * ALPHA + acc[ai][bj][m][1]; } }
    }
};
struct EpiRelu2 {
    static constexpr bool PERM = true, AFTER_DRAIN = false;
    bf16_t* O;
    __device__ __forceinline__ void operator()(Acc acc, const Unit& u, int wr, int wc, int fr, int fq) const {
        const int row0 = u.pm * 256 + wr * 64 + fr, col0 = u.pn * 256 + wc * 32 + 8 * fq;
#pragma unroll
        for (int ai = 0; ai < 2; ++ai)
#pragma unroll
            for (int m = 0; m < 4; ++m) { bf16_t* rp = O + (size_t)(row0 + ai * 128 + m * 16) * FF + col0;
#pragma unroll
                for (int bj = 0; bj < 2; ++bj) { f32x4 a = acc[ai][bj][m][0], b = acc[ai][bj][m][1];
#pragma unroll
                    for (int i = 0; i < 4; ++i) { a[i] = a[i] > 0.f ? a[i] * a[i] : 0.f; b[i] = b[i] > 0.f ? b[i] * b[i] : 0.f; }
                    *(u32x4*)(rp + bj * 128) = pack8(a, b); } }
    }
};
}
namespace pattn {
typedef short bf16x8 __attribute__((ext_vector_type(8)));
typedef short s16x4 __attribute__((ext_vector_type(4)));
typedef float f32x16 __attribute__((ext_vector_type(16)));
typedef unsigned u32x4 __attribute__((ext_vector_type(4)));
typedef __attribute__((address_space(3))) const char* lds_cptr;
constexpr int KSLOT = 12288, VSLOT = 8192, LDS_K = 0, LDS_V = 2 * KSLOT, LDS_WS = LDS_V + 2 * VSLOT, LDS_OST = LDS_WS + 2048, LDS_END = LDS_OST + 8 * 4096;
__device__ __forceinline__ int crow(int r, int hi) { return (r & 3) + 8 * (r >> 2) + 4 * hi; }
__device__ __forceinline__ void glds16(const void* gsrc, unsigned lds_dst) { unsigned keep;
    asm volatile("s_mov_b32 %0, m0\n\ts_mov_b32 m0, %2\n\ts_nop 0\n\tglobal_load_lds_dwordx4 %1, off\n\ts_mov_b32 m0, %0" : "=&s"(keep) : "v"(gsrc), "s"(lds_dst) : "memory"); }
__device__ __forceinline__ s16x4 vtr(lds_cptr p) { return __builtin_bit_cast(s16x4, __builtin_amdgcn_ds_read_tr16_b64_v4i16((__attribute__((address_space(3))) s16x4*)p)); }
__device__ __forceinline__ unsigned cvtpk(float lo, float hi) { return epi::cvt_pk_bf16(lo, hi); }
__device__ __forceinline__ float swapmax(float m) { auto rr = __builtin_amdgcn_permlane32_swap(__float_as_uint(m), __float_as_uint(m), false, false); return fmaxf(__uint_as_float(rr[0]), __uint_as_float(rr[1])); }
__device__ __forceinline__ float swapsum(float m) { auto rr = __builtin_amdgcn_permlane32_swap(__float_as_uint(m), __float_as_uint(m), false, false); return __uint_as_float(rr[0]) + __uint_as_float(rr[1]); }

__device__ __forceinline__ void prompt_unit(int b, int h, int qb, const bf16* Q, const bf16* KV, const bf16* KPE, bf16* O, LAS unsigned char* shm) {
    const int tid = threadIdx.x, lane = tid & 63, r32 = lane & 31, hi = lane >> 5; const int wid = __builtin_amdgcn_readfirstlane(tid >> 6);
    const long rowbase = (long)b * SEQ; const int q0 = qb * 256, NT = 4 * qb + 4;
    const unsigned lds0 = (unsigned)(uintptr_t)shm;
    LAS float* wsf = (LAS float*)(shm + LDS_WS) + wid * 64;
    const lds_cptr shm3 = (lds_cptr)shm;
    const bf16* Qw = Q + (rowbase + q0 + wid * 32 + r32) * 768 + h * QHD;
    bf16x8 qr[6];
#pragma unroll
    for (int d0 = 0; d0 < 6; ++d0) qr[d0] = *(const bf16x8*)(Qw + d0 * 16 + hi * 8);
    const int vr = 16 * (wid & 3) + (lane >> 2);
    const bf16* kmeta = KV + (long)(ROW_M + (lane < NMETA ? lane : NMETA - 1)) * 1024 + h * NOPE + wid * 8;
    const bf16* pmeta = KPE + (long)(ROW_M + (lane < NMETA ? lane : NMETA - 1)) * ROPE + (wid & 3) * 8;
    const bf16* vmeta = KV + (long)(ROW_M + (vr < NMETA ? vr : NMETA - 1)) * 1024 + 512 + h * VHD + (wid >> 2) * 32 + (lane & 3) * 8;
    const bf16* kreal = KV + (rowbase + lane) * 1024 + h * NOPE + wid * 8;
    const bf16* preal = KPE + (rowbase + lane) * ROPE + (wid & 3) * 8;
    const bf16* vreal = KV + (rowbase + vr) * 1024 + 512 + h * VHD + (wid >> 2) * 32 + (lane & 3) * 8;
#define PA_DMA(tt, slot) do { const int tt_ = (tt); const unsigned ks_ = lds0 + LDS_K + (slot) * KSLOT, vs_ = lds0 + LDS_V + (slot) * VSLOT; \
        glds16(tt_ == 0 ? kmeta : kreal + (long)(tt_ - 1) * 64 * 1024, (unsigned)__builtin_amdgcn_readfirstlane(ks_ + wid * 1024)); \
        if (wid < 4) glds16(tt_ == 0 ? pmeta : preal + (long)(tt_ - 1) * 64 * ROPE, (unsigned)__builtin_amdgcn_readfirstlane(ks_ + (8 + wid) * 1024)); \
        glds16(tt_ == 0 ? vmeta : vreal + (long)(tt_ - 1) * 64 * 1024, (unsigned)__builtin_amdgcn_readfirstlane(vs_ + wid * 1024)); } while (0)
    f32x16 o0 = {}, o1 = {}; float mrun = -INFINITY, lsum = 0.f;
    const int qrel = wid * 32 + r32;
    PA_DMA(0, 0);
    for (int tt = 0; tt <= NT; ++tt) {
        const int slot = tt & 1;
        asm volatile("s_waitcnt vmcnt(0) lgkmcnt(0)\n\ts_barrier" ::: "memory");
        if (tt < NT) PA_DMA(tt + 1, slot ^ 1);
        const int jb = tt - 1 - (NT - 4);
        if (tt > 0 && jb >= 0 && wid < 2 * jb) continue;
        const lds_cptr kp = shm3 + LDS_K + slot * KSLOT + hi * 1024 + r32 * 16;
        f32x16 p0 = {}, p1 = {};
#pragma unroll
        for (int d0 = 0; d0 < 6; ++d0) { const bf16x8 k0 = *(const __attribute__((address_space(3))) bf16x8*)(kp + d0 * 2048), k1 = *(const __attribute__((address_space(3))) bf16x8*)(kp + d0 * 2048 + 512);
            p0 = __builtin_amdgcn_mfma_f32_32x32x16_bf16(k0, qr[d0], p0, 0, 0, 0); p1 = __builtin_amdgcn_mfma_f32_32x32x16_bf16(k1, qr[d0], p1, 0, 0, 0); }
        if (tt == 0) {
#pragma unroll
            for (int r = 0; r < 16; ++r) { if (r >= 8) p0[r] = -INFINITY; p1[r] = -INFINITY; }
        } else if (jb >= 0) { const int kb = 64 * jb + 4 * hi;
#pragma unroll
            for (int r = 0; r < 16; ++r) { const int kv = kb + (r & 3) + 8 * (r >> 2); if (kv > qrel) p0[r] = -INFINITY; if (kv + 32 > qrel) p1[r] = -INFINITY; } }
        float mt = fmaxf(p0[0], p1[0]);
#pragma unroll
        for (int r = 1; r < 16; ++r) mt = fmaxf(mt, fmaxf(p0[r], p1[r]));
        mt = swapmax(mt);
        if (__any(mt > mrun)) {
            const float mnew = fmaxf(mrun, mt), alpha = __builtin_amdgcn_exp2f(mrun - mnew); lsum *= alpha; mrun = mnew;
            if (hi == 0) wsf[r32] = alpha;
#pragma unroll
            for (int r = 0; r < 16; ++r) { const float a = wsf[crow(r, hi)]; o0[r] *= a; o1[r] *= a; }
        }
        float ps = 0.f;
#pragma unroll
        for (int r = 0; r < 16; ++r) { p0[r] = __builtin_amdgcn_exp2f(p0[r] - mrun); p1[r] = __builtin_amdgcn_exp2f(p1[r] - mrun); ps += p0[r] + p1[r]; }
        lsum += ps;
        u32x4 pw0, pw1, pw2, pw3;
        pw0 = (u32x4){cvtpk(p0[0], p0[1]), cvtpk(p0[2], p0[3]), cvtpk(p0[4], p0[5]), cvtpk(p0[6], p0[7])};
        pw1 = (u32x4){cvtpk(p0[8], p0[9]), cvtpk(p0[10], p0[11]), cvtpk(p0[12], p0[13]), cvtpk(p0[14], p0[15])};
        pw2 = (u32x4){cvtpk(p1[0], p1[1]), cvtpk(p1[2], p1[3]), cvtpk(p1[4], p1[5]), cvtpk(p1[6], p1[7])};
        pw3 = (u32x4){cvtpk(p1[8], p1[9]), cvtpk(p1[10], p1[11]), cvtpk(p1[12], p1[13]), cvtpk(p1[14], p1[15])};
        const lds_cptr vp = shm3 + LDS_V + slot * VSLOT + ((lane >> 4) & 1) * 32 + (lane & 3) * 8 + (4 * hi + ((lane & 15) >> 2)) * 64;
#define PA_VF(d0, ks) ({ const s16x4 lo_ = vtr(vp + (d0) * 4096 + (ks) * 1024), hi_ = vtr(vp + (d0) * 4096 + (ks) * 1024 + 512); (bf16x8){lo_[0], lo_[1], lo_[2], lo_[3], hi_[0], hi_[1], hi_[2], hi_[3]}; })
        o0 = __builtin_amdgcn_mfma_f32_32x32x16_bf16(__builtin_bit_cast(bf16x8, pw0), PA_VF(0, 0), o0, 0, 0, 0);
        o1 = __builtin_amdgcn_mfma_f32_32x32x16_bf16(__builtin_bit_cast(bf16x8, pw0), PA_VF(1, 0), o1, 0, 0, 0);
        o0 = __builtin_amdgcn_mfma_f32_32x32x16_bf16(__builtin_bit_cast(bf16x8, pw1), PA_VF(0, 1), o0, 0, 0, 0);
        o1 = __builtin_amdgcn_mfma_f32_32x32x16_bf16(__builtin_bit_cast(bf16x8, pw1), PA_VF(1, 1), o1, 0, 0, 0);
        o0 = __builtin_amdgcn_mfma_f32_32x32x16_bf16(__builtin_bit_cast(bf16x8, pw2), PA_VF(0, 2), o0, 0, 0, 0);
        o1 = __builtin_amdgcn_mfma_f32_32x32x16_bf16(__builtin_bit_cast(bf16x8, pw2), PA_VF(1, 2), o1, 0, 0, 0);
        o0 = __builtin_amdgcn_mfma_f32_32x32x16_bf16(__builtin_bit_cast(bf16x8, pw3), PA_VF(0, 3), o0, 0, 0, 0);
        o1 = __builtin_amdgcn_mfma_f32_32x32x16_bf16(__builtin_bit_cast(bf16x8, pw3), PA_VF(1, 3), o1, 0, 0, 0);
#undef PA_VF
    }
#undef PA_DMA
    lsum = swapsum(lsum);
    if (hi == 0) wsf[32 + r32] = lsum;
    float rli[16];
#pragma unroll
    for (int r = 0; r < 16; ++r) rli[r] = 1.0f / wsf[32 + crow(r, hi)];
    LAS bf16* stg = (LAS bf16*)(shm + LDS_OST) + wid * 2048;
#pragma unroll
    for (int r = 0; r < 16; ++r) { const int orow = crow(r, hi); const unsigned w = cvtpk(o0[r] * rli[r], o1[r] * rli[r]);
        stg[orow * 64 + r32] = (bf16)(w & 0xffffu); stg[orow * 64 + 32 + r32] = (bf16)(w >> 16); }
    bf16* Ow = O + (rowbase + q0 + wid * 32) * 512 + h * VHD;
#pragma unroll
    for (int i = 0; i < 4; ++i) { const int row = i * 8 + (lane >> 3), ch = lane & 7; const u32x4 v = *(const LAS u32x4*)(stg + row * 64 + ch * 8); *(u32x4*)(Ow + (long)row * 512 + ch * 8) = v; }
    asm volatile("s_waitcnt lgkmcnt(0)\n\ts_barrier" ::: "memory");
}

__device__ __forceinline__ void prompt_phase(int vcu, int nvcu, const bf16* Q, const bf16* KV, const bf16* KPE, bf16* O, LAS unsigned char* shm) {
    for (int v = vcu; v < 256; v += nvcu) {
        const int bh = v >> 1, b = bh >> 3, h = bh & 7, half = v & 1;
#pragma unroll 1
        for (int i = 0; i < 4; ++i) { const int qb = half == 0 ? (i == 0 ? 0 : i == 1 ? 7 : i == 2 ? 1 : 6) : (i == 0 ? 2 : i == 1 ? 5 : i == 2 ? 3 : 4);
            prompt_unit(b, h, qb, Q, KV, KPE, O, shm); }
    }
}
}

namespace dattn {
using pattn::bf16x8; using pattn::s16x4; using pattn::f32x16; using pattn::u32x4; using pattn::lds_cptr; using pattn::crow; using pattn::vtr; using pattn::cvtpk; using pattn::swapmax; using pattn::swapsum;
typedef unsigned u32x2 __attribute__((ext_vector_type(2)));
constexpr int TILE = 36864, LQ = 0, LK = TILE, LWS = 3 * TILE, LDS_END = LWS + 2048;
__device__ __forceinline__ unsigned off_a(unsigned row, unsigned ch) { return 4608u * (row >> 3) + 512u * (ch >> 2) + 64u * (row & 7) + 16u * ((ch & 3) ^ ((row >> 2) & 3)); }

__device__ __forceinline__ void decode_unit(int db, int half, const float* cache_ckv, const float* cache_kpe, const int* page_table, const bf16* Q, const bf16* QLAT, const bf16* CKV, const bf16* KPE,
                                            float* PART, LAS unsigned char* shm) {
    const int tid = threadIdx.x, lane = tid & 63, r32 = lane & 31, hi = lane >> 5; const int wid = __builtin_amdgcn_readfirstlane(tid >> 6);
    const int rb = wid & 1, kq = (wid >> 1) & 1, chalf = wid >> 2;
    LAS float* wsf = (LAS float*)(shm + LWS) + wid * 64;
    const lds_cptr shm3 = (lds_cptr)shm;
    for (int idx = tid; idx < 64 * 36; idx += 512) { const int row = idx / 36, ch = idx - row * 36, j = row >> 3, h = row & 7;
        const bf16* src = ch < 32 ? QLAT + (size_t)(db * DSEQ + j) * 2048 + h * KVL + ch * 8 : Q + (size_t)(ROW_S + db * DSEQ + j) * 768 + h * QHD + NOPE + (ch - 32) * 8;
        *(LAS u32x4*)(shm + LQ + off_a(row, ch)) = *(const u32x4*)src; }
    const int NPGH = NPG / 2, NT = NPGH * 2;
    const int myphys = page_table[db * NPG + half * NPGH + (lane & 31)];
    f32x4 st[9];
#define DA_LOAD(tt) do { const int phys_ = __builtin_amdgcn_readlane(myphys, (tt) >> 1); const size_t kb_ = (size_t)phys_ * PAGE + ((tt) & 1) * 64; \
        _Pragma("unroll") for (int i = 0; i < 8; ++i) st[i] = *(const f32x4*)(cache_ckv + (kb_ + i * 8 + wid) * KVL + 4 * lane); \
        st[8] = *(const f32x4*)(cache_kpe + (kb_ + (tid >> 3)) * ROPE + 4 * (tid & 7)); } while (0)
#define DA_STORE(buf) do { LAS unsigned char* kb_ = shm + LK + (buf) * TILE; \
        _Pragma("unroll") for (int i = 0; i < 8; ++i) { u32x2 w; w.x = cvtpk(st[i].x, st[i].y); w.y = cvtpk(st[i].z, st[i].w); *(LAS u32x2*)(kb_ + off_a(i * 8 + wid, lane >> 1) + 8 * (lane & 1)) = w; } \
        { u32x2 w; w.x = cvtpk(st[8].x, st[8].y); w.y = cvtpk(st[8].z, st[8].w); *(LAS u32x2*)(kb_ + off_a(tid >> 3, 32 + ((tid & 7) >> 1)) + 8 * (tid & 1)) = w; } } while (0)
    f32x16 o[4] = {{}, {}, {}, {}}; float mrun = -INFINITY, lsum = 0.f;
    const unsigned krow = 32 * kq + r32, qrow = 32 * rb + r32;
    const unsigned vq = (lane & 15) >> 2, vp_ = lane & 3, vblk = (lane >> 4) & 1;
#define DA_COMPUTE(buf, NEWTILE) do { \
        const lds_cptr kbase = shm3 + LK + (buf) * TILE; const lds_cptr qbase = shm3 + LQ; \
        f32x16 p = {}; \
        _Pragma("unroll") for (int s = 0; s < 18; ++s) { const bf16x8 kf = *(const __attribute__((address_space(3))) bf16x8*)(kbase + off_a(krow, 2 * s + hi)); \
            const bf16x8 qf = *(const __attribute__((address_space(3))) bf16x8*)(qbase + off_a(qrow, 2 * s + hi)); p = __builtin_amdgcn_mfma_f32_32x32x16_bf16(kf, qf, p, 0, 0, 0); } \
        if (NEWTILE) { const int tok = (int)qrow >> 3; _Pragma("unroll") for (int r = 0; r < 16; ++r) { const int key = crow(r, hi); if (key >= DSEQ || key > tok) p[r] = -INFINITY; } } \
        float mt = p[0]; _Pragma("unroll") for (int r = 1; r < 16; ++r) mt = fmaxf(mt, p[r]); \
        mt = swapmax(mt); \
        if (__any(mt > mrun)) { const float mnew = fmaxf(mrun, mt), alpha = __builtin_amdgcn_exp2f(mrun - mnew); lsum *= alpha; mrun = mnew; \
            if (hi == 0) wsf[r32] = alpha; \
            _Pragma("unroll") for (int r = 0; r < 16; ++r) { const float a = wsf[crow(r, hi)]; o[0][r] *= a; o[1][r] *= a; o[2][r] *= a; o[3][r] *= a; } } \
        float ps = 0.f; _Pragma("unroll") for (int r = 0; r < 16; ++r) { p[r] = __builtin_amdgcn_exp2f(p[r] - mrun); ps += p[r]; } \
        lsum += ps; \
        const u32x4 pw0 = (u32x4){cvtpk(p[0], p[1]), cvtpk(p[2], p[3]), cvtpk(p[4], p[5]), cvtpk(p[6], p[7])}, pw1 = (u32x4){cvtpk(p[8], p[9]), cvtpk(p[10], p[11]), cvtpk(p[12], p[13]), cvtpk(p[14], p[15])}; \
        _Pragma("unroll") for (int s = 0; s < 2; ++s) _Pragma("unroll") for (int c4 = 0; c4 < 4; ++c4) { const unsigned cb = 4 * chalf + c4; \
            const s16x4 lo_ = vtr(kbase + off_a(32 * kq + 16 * s + 4 * hi + vq, 4 * cb + 2 * vblk + (vp_ >> 1)) + 8 * (vp_ & 1)), \
                        hi_ = vtr(kbase + off_a(32 * kq + 16 * s + 8 + 4 * hi + vq, 4 * cb + 2 * vblk + (vp_ >> 1)) + 8 * (vp_ & 1)); \
            const bf16x8 vf = (bf16x8){lo_[0], lo_[1], lo_[2], lo_[3], hi_[0], hi_[1], hi_[2], hi_[3]}; \
            o[c4] = __builtin_amdgcn_mfma_f32_32x32x16_bf16(__builtin_bit_cast(bf16x8, s == 0 ? pw0 : pw1), vf, o[c4], 0, 0, 0); } \
    } while (0)
    DA_LOAD(0);
    DA_STORE(0);
    asm volatile("s_waitcnt lgkmcnt(0)\n\ts_barrier" ::: "memory");
#pragma unroll 1
    for (int tt = 0; tt < NT; ++tt) {
        const int buf = tt & 1;
        if (tt + 1 < NT) DA_LOAD(tt + 1);
        DA_COMPUTE(buf, false);
        if (tt + 1 < NT) DA_STORE(buf ^ 1);
        asm volatile("s_waitcnt lgkmcnt(0)\n\ts_barrier" ::: "memory");
    }
    if (half == 1) {
        if (tid < DSEQ * 36) { const int key = tid / 36, ch = tid - key * 36; const size_t krow_g = (size_t)ROW_S + db * DSEQ + key;
            const bf16* src = ch < 32 ? CKV + krow_g * KVL + ch * 8 : KPE + krow_g * ROPE + (ch - 32) * 8;
            *(LAS u32x4*)(shm + LK + off_a(key, ch)) = *(const u32x4*)src; }
        asm volatile("s_waitcnt vmcnt(0) lgkmcnt(0)\n\ts_barrier" ::: "memory");
        if (kq == 0) DA_COMPUTE(0, true);
    }
#undef DA_LOAD
#undef DA_STORE
#undef DA_COMPUTE
    lsum = swapsum(lsum);
    float* dst = PART + ((size_t)(db * NSPLIT + half * 2 + kq) * 64 + 32 * rb) * 264;
#pragma unroll
    for (int c4 = 0; c4 < 4; ++c4)
#pragma unroll
        for (int r = 0; r < 16; ++r) dst[(size_t)crow(r, hi) * 264 + 32 * (4 * chalf + c4) + r32] = o[c4][r];
    if (chalf == 0 && hi == 0) { dst[(size_t)r32 * 264 + 256] = mrun; dst[(size_t)r32 * 264 + 257] = lsum; }
    asm volatile("s_waitcnt lgkmcnt(0)\n\ts_barrier" ::: "memory");
}
}
struct Frame {
    LAS unsigned char* lds;
    volatile LAS unsigned* MISC;
    gu32* ctl;
    int tid, lane, wave;
    int vcu, G;
    const float *x_prompt, *x_sample, *cache_ckv, *cache_kpe, *state_conv; const int* page_table; const float *meta, *lne_g, *lne_b, *w_in, *qn_g, *w_uq, *kvn_g, *w_uk, *w_uv, *w_o_mla,
        *conv_w, *w_conv_out, *w_o, *ln1_g, *ln1_b, *w_up, *w_down, *ln2_g, *ln2_b;
    float* out; unsigned char* ws;
};
#define WSP(T, off) ((T*)(F.ws + (off)))

__device__ __forceinline__ float wave_sum(float v) {
#pragma unroll
    for (int o = 1; o < 64; o <<= 1) v += __shfl_xor(v, o);
    return v;
}
__device__ __forceinline__ float bf2f(unsigned short h) { return __uint_as_float((unsigned)h << 16); }
__device__ __forceinline__ float bflo(unsigned u) { return __uint_as_float(u << 16); }
__device__ __forceinline__ float bfhi(unsigned u) { return __uint_as_float(u & 0xffff0000u); }

__device__ __forceinline__ void p0_transpose_item(const float* W, int ldw, bf16* WT, int ldt, int k0, int srcn0, int dstn0, LAS float* scr, int lane) {
    if (srcn0 >= 0) {
#pragma unroll 8
        for (int i = 0; i < 32; ++i) { const int kk = 2 * i + (lane >> 5); scr[kk * 33 + (lane & 31)] = W[(size_t)(k0 + kk) * ldw + srcn0 + (lane & 31)]; }
    } else {
#pragma unroll 8
        for (int i = 0; i < 32; ++i) { const int kk = 2 * i + (lane >> 5); scr[kk * 33 + (lane & 31)] = 0.f; }
    }
    LDS_WAIT(); asm volatile("" ::: "memory");
    const int c = lane & 7;
#pragma unroll
    for (int j = 0; j < 4; ++j) { const int n = (lane >> 3) + 8 * j; const LAS float* s = scr + (8 * c) * 33 + n;
        v4u o; o.x = pk2(s[0 * 33], s[1 * 33]); o.y = pk2(s[2 * 33], s[3 * 33]); o.z = pk2(s[4 * 33], s[5 * 33]); o.w = pk2(s[6 * 33], s[7 * 33]);
        *(GAS v4u*)(WT + (size_t)(dstn0 + n) * ldt + k0 + 8 * c) = o; }
    LDS_WAIT(); asm volatile("" ::: "memory");
}
__device__ __forceinline__ int win_src_col(int n) {
    if (n < 384) return ZC_CQ + n;
    if (n < 416) return ZC_KPE + (n - 384);
    if (n < 512) return -1;
    if (n < 768) return ZC_CKV + (n - 512);
    if (n < 1280) return ZC_GB + (n - 768);
    if (n < 2304) { const int q = n - 1280, p = q >> 8, j = q & 255; return j < 128 ? ZC_GC + 128 * p + j : ZC_CH + 128 * p + (j - 128); }
    if (n < 3328) return ZC_GCV + (n - 2304);
    return ZC_GML + (n - 3328);
}
__device__ __forceinline__ void sincos_d(double a, double& s, double& c) {
    const double n = __builtin_rint(a * 0.63661977236758138);
    double r = __builtin_fma(-n, 1.5707963267948966, a); r = __builtin_fma(-n, 6.123233995736766e-17, r);
    const double r2 = r * r;
    double sp = -1.0 / 1307674368000.0; sp = sp * r2 + 1.0 / 6227020800.0; sp = sp * r2 - 1.0 / 39916800.0; sp = sp * r2 + 1.0 / 362880.0; sp = sp * r2 - 1.0 / 5040.0; sp = sp * r2 + 1.0 / 120.0; sp = sp * r2 - 1.0 / 6.0; sp = sp * r2 + 1.0; sp *= r;
    double cp = 1.0 / 20922789888000.0; cp = cp * r2 - 1.0 / 87178291200.0; cp = cp * r2 + 1.0 / 479001600.0; cp = cp * r2 - 1.0 / 3628800.0; cp = cp * r2 + 1.0 / 40320.0; cp = cp * r2 - 1.0 / 720.0; cp = cp * r2 + 1.0 / 24.0; cp = cp * r2 - 0.5; cp = cp * r2 + 1.0;
    const int q = ((int)n) & 3;
    s = (q == 0) ? sp : (q == 1) ? cp : (q == 2) ? -sp : -cp;
    c = (q == 0) ? cp : (q == 1) ? -sp : (q == 2) ? -cp : sp;
}
__device__ __forceinline__ void ln_row(f32x4 (&v)[4], const float* g, const float* b, int lane) {
    float s = 0.f;
#pragma unroll
    for (int j = 0; j < 4; ++j) s += (v[j].x + v[j].y) + (v[j].z + v[j].w);
    const float mean = wave_sum(s) * (1.f / D); float s2 = 0.f;
#pragma unroll
    for (int j = 0; j < 4; ++j) { v[j] = v[j] - mean; s2 += (v[j].x * v[j].x + v[j].y * v[j].y) + (v[j].z * v[j].z + v[j].w * v[j].w); }
    const float rstd = 1.f / sqrtf(wave_sum(s2) * (1.f / D) + LN_EPS);
#pragma unroll
    for (int j = 0; j < 4; ++j) { const f32x4 gg = *(const f32x4*)(g + 4 * lane + 256 * j), bb = *(const f32x4*)(b + 4 * lane + 256 * j); v[j] = v[j] * rstd * gg + bb; }
}

__device__ __forceinline__ void p0_prologue(Frame& F) {
    LAS float* scr = (LAS float*)(F.lds + RING_OFF + F.wave * 16384);
    const int gw = F.vcu * NWAVES + F.wave, NGW = F.G * NWAVES, lane = F.lane;
    constexpr int I_IN = (D / 64) * (NZ / 32), I_UQ = (QLORA / 64) * (768 / 32), I_KV = (KVL / 64) * (1024 / 32), I_CO = (CDIM / 64) * (D / 32), I_OM = (512 / 64) * (D / 32),
                  I_O = (D / 64) * (D / 32), I_UP = (D / 64) * (FF / 32), I_DN = (FF / 64) * (D / 32);
    constexpr int NITEMS = I_IN + I_UQ + I_KV + I_CO + I_OM + I_O + I_UP + I_DN;
    for (int it = gw; it < NITEMS; it += NGW) {
        int r = it;
        if (r < I_IN) { const int nb = r % (NZ / 32), kb = r / (NZ / 32); p0_transpose_item(F.w_in, DIN, WSP(bf16, WS_WIN), D, 64 * kb, win_src_col(32 * nb), 32 * nb, scr, lane); continue; } r -= I_IN;
        if (r < I_UQ) { const int nb = r % 24, kb = r / 24; p0_transpose_item(F.w_uq, 768, WSP(bf16, WS_WUQ), QLORA, 64 * kb, 32 * nb, 32 * nb, scr, lane); continue; } r -= I_UQ;
        if (r < I_KV) { const int nb = r % 32, kb = r / 32; p0_transpose_item(nb < 16 ? F.w_uk : F.w_uv, 512, WSP(bf16, WS_WKV), KVL, 64 * kb, 32 * (nb & 15), 32 * nb, scr, lane); continue; } r -= I_KV;
        if (r < I_CO) { const int nb = r % 32, kb = r / 32; p0_transpose_item(F.w_conv_out, D, WSP(bf16, WS_WCO), CDIM, 64 * kb, 32 * nb, 32 * nb, scr, lane); continue; } r -= I_CO;
        if (r < I_OM) { const int nb = r % 32, kb = r / 32; p0_transpose_item(F.w_o_mla, D, WSP(bf16, WS_WOM), 512, 64 * kb, 32 * nb, 32 * nb, scr, lane); continue; } r -= I_OM;
        if (r < I_O) { const int nb = r % 32, kb = r / 32; p0_transpose_item(F.w_o, D, WSP(bf16, WS_WO), D, 64 * kb, 32 * nb, 32 * nb, scr, lane); continue; } r -= I_O;
        if (r < I_UP) { const int nb = r % 128, kb = r / 128; p0_transpose_item(F.w_up, FF, WSP(bf16, WS_WUP), D, 64 * kb, 32 * nb, 32 * nb, scr, lane); continue; } r -= I_UP;
        { const int nb = r % 32, kb = r / 32; p0_transpose_item(F.w_down, D, WSP(bf16, WS_WDN), FF, 64 * kb, 32 * nb, 32 * nb, scr, lane); }
    }
    for (int n = gw; n < NH * KVL; n += NGW) {
        const int h = n >> 8, c = n & 255; const float* uk = F.w_uk + (size_t)c * 512 + h * 64;
        bf16* dst = WSP(bf16, WS_WABS) + (size_t)n * QLORA;
        for (int j = 0; j < QLORA / 64; ++j) { const int k = lane + 64 * j; const float* uq = F.w_uq + (size_t)k * 768 + h * 96; float s = 0.f;
#pragma unroll 4
            for (int i = 0; i < 16; ++i) { const f32x4 a = *(const f32x4*)(uq + 4 * i), b = *(const f32x4*)(uk + 4 * i); s += (a.x * b.x + a.y * b.y) + (a.z * b.z + a.w * b.w); }
            dst[k] = (bf16)f2bf(s); }
    }
    for (int e = F.vcu * (NWAVES * 64) + F.tid; e < NTAB * 16; e += F.G * NWAVES * 64) {
        const int tp = e >> 4, i = e & 15; const int pos = tp < LP ? tp : PAST + (tp - LP);
        double inv = 1.0; for (int j = 0; j < i; ++j) inv *= 0.56234132519034908;
        const float inv_f = (float)inv; const float ang = (float)pos * inv_f;
        double s, c; sincos_d((double)ang, s, c);
        float* t = WSP(float, WS_TAB) + (size_t)tp * 32; t[i] = (float)c; t[16 + i] = (float)s;
    }
    for (int m = gw; m < M_ALL; m += NGW) {
        GAS unsigned long long* o8 = (GAS unsigned long long*)(WSP(bf16, WS_XN) + (size_t)m * D) + lane;
        if (m >= ROW_M + NMETA) {
#pragma unroll
            for (int j = 0; j < 4; ++j) o8[64 * j] = 0ull;
            continue; }
        const float* xrow = m < M_P ? F.x_prompt + (size_t)m * D : (m < ROW_M ? F.x_sample + (size_t)(m - ROW_S) * D : F.meta + (size_t)(m - ROW_M) * D);
        const GAS f32x4* xr = (const GAS f32x4*)xrow + lane;
        f32x4 v[4];
#pragma unroll
        for (int j = 0; j < 4; ++j) v[j] = xr[64 * j];
        ln_row(v, F.lne_g, F.lne_b, lane);
#pragma unroll
        for (int j = 0; j < 4; ++j) o8[64 * j] = (unsigned long long)pk2(v[j].x, v[j].y) | ((unsigned long long)pk2(v[j].z, v[j].w) << 32);
    }
}

__device__ __forceinline__ void p2_thin(Frame& F) {
    const int gw = F.vcu * NWAVES + F.wave, NGW = F.G * NWAVES, lane = F.lane;
    const float* ZF = WSP(float, WS_ZF); const bf16* GB = WSP(bf16, WS_GB); const bf16* U = WSP(bf16, WS_U);
    for (int m = gw; m < ROW_M + NMETA; m += NGW) {
        const float* z = ZF + (size_t)m * 768;
        { const f32x4 a = *(const f32x4*)(z + 4 * lane); const float b0 = z[256 + 2 * lane], b1 = z[256 + 2 * lane + 1];
          const float ss = wave_sum((a.x * a.x + a.y * a.y) + (a.z * a.z + a.w * a.w) + (b0 * b0 + b1 * b1));
          const float sc = 1.f / sqrtf(ss * (1.f / QLORA) + RMS_EPS);
          const f32x4 g = *(const f32x4*)(F.qn_g + 4 * lane); const float g0 = F.qn_g[256 + 2 * lane], g1 = F.qn_g[256 + 2 * lane + 1];
          bf16* o = WSP(bf16, WS_CQN) + (size_t)m * QLORA;
          *(unsigned long long*)(o + 4 * lane) = (unsigned long long)pk2(a.x * sc * g.x, a.y * sc * g.y) | ((unsigned long long)pk2(a.z * sc * g.z, a.w * sc * g.w) << 32);
          *(unsigned*)(o + 256 + 2 * lane) = pk2(b0 * sc * g0, b1 * sc * g1); }
        { const f32x4 a = *(const f32x4*)(z + 512 + 4 * lane);
          const float ss = wave_sum((a.x * a.x + a.y * a.y) + (a.z * a.z + a.w * a.w));
          const float sc = 1.f / sqrtf(ss * (1.f / KVL) + RMS_EPS);
          const f32x4 g = *(const f32x4*)(F.kvn_g + 4 * lane); const f32x4 v = a * sc * g;
          *(unsigned long long*)(WSP(bf16, WS_CKV) + (size_t)m * KVL + 4 * lane) = (unsigned long long)pk2(v.x, v.y) | ((unsigned long long)pk2(v.z, v.w) << 32);
          if (m < M_P) *(f32x4*)(F.out + O_CKVP + ((size_t)(m >> 11) * LP + NMETA + (m & (SEQ - 1))) * KVL + 4 * lane) = v;
          else if (m < ROW_M) *(f32x4*)(F.out + O_CKVS + (size_t)(m - ROW_S) * KVL + 4 * lane) = v;
          else for (int b = 0; b < NB; ++b) *(f32x4*)(F.out + O_CKVP + ((size_t)b * LP + (m - ROW_M)) * KVL + 4 * lane) = v; }
        if (lane < 16) { const float x1 = z[384 + lane], x2 = z[384 + 16 + lane]; const float* t = WSP(float, WS_TAB) + (size_t)epi::tab_pos(m) * 32; const float cs = t[lane], sn = t[16 + lane];
          const float y1 = x1 * cs - x2 * sn, y2 = x2 * cs + x1 * sn;
          bf16* o = WSP(bf16, WS_KPE) + (size_t)m * ROPE; o[lane] = (bf16)f2bf(y1); o[16 + lane] = (bf16)f2bf(y2);
          if (m < M_P) { float* p = F.out + O_KPEP + ((size_t)(m >> 11) * LP + NMETA + (m & (SEQ - 1))) * ROPE; p[lane] = y1; p[16 + lane] = y2; }
          else if (m < ROW_M) { float* p = F.out + O_KPES + (size_t)(m - ROW_S) * ROPE; p[lane] = y1; p[16 + lane] = y2; }
          else for (int b = 0; b < NB; ++b) { float* p = F.out + O_KPEP + ((size_t)b * LP + (m - ROW_M)) * ROPE; p[lane] = y1; p[16 + lane] = y2; } }
        if (m < ROW_M) {
            const int c0 = 8 * lane; float u0[8], u1[8], u2[8];
            { const v4u r = *(const v4u*)(U + (size_t)m * CDIM + c0); u0[0] = bflo(r.x); u0[1] = bfhi(r.x); u0[2] = bflo(r.y); u0[3] = bfhi(r.y); u0[4] = bflo(r.z); u0[5] = bfhi(r.z); u0[6] = bflo(r.w); u0[7] = bfhi(r.w); }
#pragma unroll
            for (int d = 1; d <= 2; ++d) { float* dst = d == 1 ? u1 : u2; int src = -1; const float* st = nullptr;
                if (m < M_P) { const int t = m & (SEQ - 1); src = t >= d ? m - d : ROW_M + NMETA - (d - t); }
                else { const int j = (m - ROW_S) & 7, db = (m - ROW_S) >> 3; if (j >= d) src = m - d; else st = F.state_conv + ((size_t)db * 2 + (2 - (d - j))) * CDIM; }
                if (src >= 0) { const v4u r = *(const v4u*)(U + (size_t)src * CDIM + c0); dst[0] = bflo(r.x); dst[1] = bfhi(r.x); dst[2] = bflo(r.y); dst[3] = bfhi(r.y); dst[4] = bflo(r.z); dst[5] = bfhi(r.z); dst[6] = bflo(r.w); dst[7] = bfhi(r.w); }
                else { const f32x4 a = *(const f32x4*)(st + c0), b = *(const f32x4*)(st + c0 + 4); dst[0] = a.x; dst[1] = a.y; dst[2] = a.z; dst[3] = a.w; dst[4] = b.x; dst[5] = b.y; dst[6] = b.z; dst[7] = b.w; } }
            const v4u gr = *(const v4u*)(GB + (size_t)m * CDIM + c0); float gb[8] = {bflo(gr.x), bfhi(gr.x), bflo(gr.y), bfhi(gr.y), bflo(gr.z), bfhi(gr.z), bflo(gr.w), bfhi(gr.w)};
            float r[8];
#pragma unroll
            for (int e = 0; e < 8; ++e) { const float w0 = F.conv_w[c0 + e], w1 = F.conv_w[CDIM + c0 + e], w2 = F.conv_w[2 * CDIM + c0 + e]; r[e] = gb[e] * (w0 * u2[e] + w1 * u1[e] + w2 * u0[e]); }
            v4u o; o.x = pk2(r[0], r[1]); o.y = pk2(r[2], r[3]); o.z = pk2(r[4], r[5]); o.w = pk2(r[6], r[7]);
            *(v4u*)(WSP(bf16, WS_CV) + (size_t)m * CDIM + c0) = o;
        }
    }
}

__device__ __forceinline__ void attn_prompt_naive(Frame& F) {
    const bf16* Q = WSP(bf16, WS_Q); const bf16* KV = WSP(bf16, WS_KV); const bf16* KPE = WSP(bf16, WS_KPE); bf16* O = WSP(bf16, WS_O);
    for (int v = blockIdx.x; v < 256; v += F.G) {
        const int bh = v >> 1, b = bh >> 3, h = bh & 7;
        for (int ii = 0; ii < 2; ++ii) {
            const int qblk = (v & 1) ? (1 + ii) : (3 * ii);
            const int t = qblk * 512 + F.tid; const size_t row = (size_t)b * SEQ + t;
            float q[QHD], o[VHD]; float mx = -INFINITY, l = 0.f;
            { const v4u* qp = (const v4u*)(Q + row * 768 + h * QHD);
#pragma unroll
              for (int i = 0; i < QHD / 8; ++i) { const v4u r = qp[i]; q[8 * i] = bflo(r.x); q[8 * i + 1] = bfhi(r.x); q[8 * i + 2] = bflo(r.y); q[8 * i + 3] = bfhi(r.y); q[8 * i + 4] = bflo(r.z); q[8 * i + 5] = bfhi(r.z); q[8 * i + 6] = bflo(r.w); q[8 * i + 7] = bfhi(r.w); } }
#pragma unroll
            for (int d = 0; d < VHD; ++d) o[d] = 0.f;
            const int tmax = qblk * 512 + F.wave * 64 + 63;
            for (int kk = -NMETA; kk <= tmax; ++kk) {
                const size_t krow = kk < 0 ? (size_t)(ROW_M + NMETA + kk) : (size_t)b * SEQ + kk;
                const v4u* kp = (const v4u*)(KV + krow * 1024 + h * NOPE); const v4u* pp = (const v4u*)(KPE + krow * ROPE); const v4u* vp = (const v4u*)(KV + krow * 1024 + 512 + h * VHD);
                float s = 0.f;
#pragma unroll
                for (int i = 0; i < 8; ++i) { const v4u r = kp[i]; s += q[8 * i] * bflo(r.x) + q[8 * i + 1] * bfhi(r.x) + q[8 * i + 2] * bflo(r.y) + q[8 * i + 3] * bfhi(r.y) + q[8 * i + 4] * bflo(r.z) + q[8 * i + 5] * bfhi(r.z) + q[8 * i + 6] * bflo(r.w) + q[8 * i + 7] * bfhi(r.w); }
#pragma unroll
                for (int i = 0; i < 4; ++i) { const v4u r = pp[i]; const int j = 64 + 8 * i; s += q[j] * bflo(r.x) + q[j + 1] * bfhi(r.x) + q[j + 2] * bflo(r.y) + q[j + 3] * bfhi(r.y) + q[j + 4] * bflo(r.z) + q[j + 5] * bfhi(r.z) + q[j + 6] * bflo(r.w) + q[j + 7] * bfhi(r.w); }
                if (kk <= t) {
                    if (s > mx) { const float a = __builtin_amdgcn_exp2f(mx - s); l *= a;
#pragma unroll
                        for (int d = 0; d < VHD; ++d) o[d] *= a;
                        mx = s; }
                    const float p = __builtin_amdgcn_exp2f(s - mx); l += p;
#pragma unroll
                    for (int i = 0; i < 8; ++i) { const v4u r = vp[i]; o[8 * i] += p * bflo(r.x); o[8 * i + 1] += p * bfhi(r.x); o[8 * i + 2] += p * bflo(r.y); o[8 * i + 3] += p * bfhi(r.y); o[8 * i + 4] += p * bflo(r.z); o[8 * i + 5] += p * bfhi(r.z); o[8 * i + 6] += p * bflo(r.w); o[8 * i + 7] += p * bfhi(r.w); }
                }
            }
            const float il = 1.f / l; v4u* op = (v4u*)(O + row * 512 + h * VHD);
#pragma unroll
            for (int i = 0; i < 8; ++i) { v4u w; w.x = pk2(o[8 * i] * il, o[8 * i + 1] * il); w.y = pk2(o[8 * i + 2] * il, o[8 * i + 3] * il); w.z = pk2(o[8 * i + 4] * il, o[8 * i + 5] * il); w.w = pk2(o[8 * i + 6] * il, o[8 * i + 7] * il); op[i] = w; }
        }
    }
}

__device__ __forceinline__ void attn_decode_naive(Frame& F) {
    const bf16* Q = WSP(bf16, WS_Q); const bf16* QLAT = WSP(bf16, WS_QLAT); const bf16* CKV = WSP(bf16, WS_CKV); const bf16* KPE = WSP(bf16, WS_KPE); float* PART = WSP(float, WS_PART);
    const int r = F.tid >> 3, part = F.tid & 7, j = r >> 3, h = r & 7;
    for (int uu = blockIdx.x; uu < DBATCH * NSPLIT; uu += F.G) {
        const int db = uu / NSPLIT, ck = uu % NSPLIT;
        float ql[32], qp[4], o[32]; float mx = -INFINITY, l = 0.f;
        { const v4u* p = (const v4u*)(QLAT + (size_t)(db * DSEQ + j) * 2048 + h * KVL + part * 32);
#pragma unroll
          for (int i = 0; i < 4; ++i) { const v4u w = p[i]; ql[8 * i] = bflo(w.x); ql[8 * i + 1] = bfhi(w.x); ql[8 * i + 2] = bflo(w.y); ql[8 * i + 3] = bfhi(w.y); ql[8 * i + 4] = bflo(w.z); ql[8 * i + 5] = bfhi(w.z); ql[8 * i + 6] = bflo(w.w); ql[8 * i + 7] = bfhi(w.w); }
          const unsigned long long w = *(const unsigned long long*)(Q + (size_t)(ROW_S + db * DSEQ + j) * 768 + h * QHD + NOPE + part * 4);
          qp[0] = bflo((unsigned)w); qp[1] = bfhi((unsigned)w); qp[2] = bflo((unsigned)(w >> 32)); qp[3] = bfhi((unsigned)(w >> 32)); }
#pragma unroll
        for (int d = 0; d < 32; ++d) o[d] = 0.f;
        const int npg = NPG / NSPLIT;
        for (int pg = ck * npg; pg < (ck + 1) * npg; ++pg) {
            const int phys = F.page_table[db * NPG + pg];
            const float* cb = F.cache_ckv + (size_t)phys * PAGE * KVL + part * 32; const float* pb = F.cache_kpe + (size_t)phys * PAGE * ROPE + part * 4;
            for (int kk = 0; kk < PAGE; ++kk) {
                float kv[32]; const f32x4* cp = (const f32x4*)(cb + (size_t)kk * KVL);
#pragma unroll
                for (int i = 0; i < 8; ++i) { const f32x4 w = cp[i]; kv[4 * i] = w.x; kv[4 * i + 1] = w.y; kv[4 * i + 2] = w.z; kv[4 * i + 3] = w.w; }
                const f32x4 kp = *(const f32x4*)(pb + (size_t)kk * ROPE);
                float s = qp[0] * kp.x + qp[1] * kp.y + qp[2] * kp.z + qp[3] * kp.w;
#pragma unroll
                for (int d = 0; d < 32; ++d) s += ql[d] * kv[d];
                s += __shfl_xor(s, 1); s += __shfl_xor(s, 2); s += __shfl_xor(s, 4);
                if (s > mx) { const float a = __builtin_amdgcn_exp2f(mx - s); l *= a;
#pragma unroll
                    for (int d = 0; d < 32; ++d) o[d] *= a;
                    mx = s; }
                const float p = __builtin_amdgcn_exp2f(s - mx); l += p;
#pragma unroll
                for (int d = 0; d < 32; ++d) o[d] += p * kv[d];
            }
        }
        if (ck == NSPLIT - 1) {
            for (int jj = 0; jj < DSEQ; ++jj) {
                const size_t krow = (size_t)ROW_S + db * DSEQ + jj; float kv[32];
                const v4u* cp = (const v4u*)(CKV + krow * KVL + part * 32);
#pragma unroll
                for (int i = 0; i < 4; ++i) { const v4u w = cp[i]; kv[8 * i] = bflo(w.x); kv[8 * i + 1] = bfhi(w.x); kv[8 * i + 2] = bflo(w.y); kv[8 * i + 3] = bfhi(w.y); kv[8 * i + 4] = bflo(w.z); kv[8 * i + 5] = bfhi(w.z); kv[8 * i + 6] = bflo(w.w); kv[8 * i + 7] = bfhi(w.w); }
                const unsigned long long w = *(const unsigned long long*)(KPE + krow * ROPE + part * 4);
                float s = qp[0] * bflo((unsigned)w) + qp[1] * bfhi((unsigned)w) + qp[2] * bflo((unsigned)(w >> 32)) + qp[3] * bfhi((unsigned)(w >> 32));
#pragma unroll
                for (int d = 0; d < 32; ++d) s += ql[d] * kv[d];
                s += __shfl_xor(s, 1); s += __shfl_xor(s, 2); s += __shfl_xor(s, 4);
                if (jj <= j) {
                    if (s > mx) { const float a = __builtin_amdgcn_exp2f(mx - s); l *= a;
#pragma unroll
                        for (int d = 0; d < 32; ++d) o[d] *= a;
                        mx = s; }
                    const float p = __builtin_amdgcn_exp2f(s - mx); l += p;
#pragma unroll
                    for (int d = 0; d < 32; ++d) o[d] += p * kv[d];
                }
            }
        }
        float* dst = PART + ((size_t)(db * NSPLIT + ck) * 64 + r) * 264;
#pragma unroll
        for (int i = 0; i < 8; ++i) *(f32x4*)(dst + part * 32 + 4 * i) = (f32x4){o[4 * i], o[4 * i + 1], o[4 * i + 2], o[4 * i + 3]};
        if (part == 0) { dst[256] = mx; dst[257] = l; }
    }
}

__device__ __forceinline__ void decode_combine(Frame& F) {
    const float* PART = WSP(float, WS_PART); bf16* O = WSP(bf16, WS_O); const bf16* WV = WSP(bf16, WS_WKV) + (size_t)512 * KVL;
    LAS float* OL = (LAS float*)(F.lds + RING_OFF);
    const int rl = F.tid >> 4, q = F.tid & 15;
    for (int uu = F.vcu; uu < DBATCH * 2; uu += F.G) {
        const int db = uu >> 1, r = 32 * (uu & 1) + rl, j = r >> 3, h = r & 7;
        const float* src0 = PART + ((size_t)db * NSPLIT * 64 + r) * 264;
        float M = -INFINITY;
#pragma unroll
        for (int k = 0; k < NSPLIT; ++k) M = fmaxf(M, src0[(size_t)k * 64 * 264 + 256]);
        float L = 0.f; f32x4 o[4] = {{0.f, 0.f, 0.f, 0.f}, {0.f, 0.f, 0.f, 0.f}, {0.f, 0.f, 0.f, 0.f}, {0.f, 0.f, 0.f, 0.f}};
#pragma unroll
        for (int k = 0; k < NSPLIT; ++k) { const float* src = src0 + (size_t)k * 64 * 264; const float a = __builtin_amdgcn_exp2f(src[256] - M); L += src[257] * a;
#pragma unroll
            for (int i = 0; i < 4; ++i) o[i] = o[i] + *(const f32x4*)(src + q * 16 + 4 * i) * a; }
        const float il = 1.f / L;
#pragma unroll
        for (int i = 0; i < 4; ++i) *(LAS f32x4*)(OL + rl * 260 + q * 16 + 4 * i) = o[i] * il;
        __syncthreads();
        float acc[4] = {0.f, 0.f, 0.f, 0.f};
        const bf16* wv = WV + (size_t)(h * VHD + q * 4) * KVL;
#pragma unroll 4
        for (int c8 = 0; c8 < KVL / 8; ++c8) { const f32x4 x0 = *(const LAS f32x4*)(OL + rl * 260 + 8 * c8), x1 = *(const LAS f32x4*)(OL + rl * 260 + 8 * c8 + 4);
#pragma unroll
            for (int e = 0; e < 4; ++e) { const v4u w = *(const v4u*)(wv + (size_t)e * KVL + 8 * c8);
                acc[e] += x0.x * bflo(w.x) + x0.y * bfhi(w.x) + x0.z * bflo(w.y) + x0.w * bfhi(w.y) + x1.x * bflo(w.z) + x1.y * bfhi(w.z) + x1.z * bflo(w.w) + x1.w * bfhi(w.w); } }
        *(unsigned long long*)(O + (size_t)(ROW_S + db * DSEQ + j) * 512 + h * VHD + q * 4) = (unsigned long long)pk2(acc[0], acc[1]) | ((unsigned long long)pk2(acc[2], acc[3]) << 32);
        __syncthreads();
    }
}

__device__ __forceinline__ void ln_pass(Frame& F, const float* R, const float* g, const float* b, float* dst32, bf16* dst16, int nrows) {
    const int gw = F.vcu * NWAVES + F.wave, NGW = F.G * NWAVES, lane = F.lane;
    for (int m = gw; m < nrows; m += NGW) {
        const GAS f32x4* xr = (const GAS f32x4*)(R + (size_t)m * D) + lane; f32x4 v[4];
#pragma unroll
        for (int j = 0; j < 4; ++j) v[j] = xr[64 * j];
        ln_row(v, g, b, lane);
        if (dst32) { GAS f32x4* o4 = (GAS f32x4*)(dst32 + (size_t)m * D) + lane;
#pragma unroll
            for (int j = 0; j < 4; ++j) o4[64 * j] = v[j]; }
        if (dst16) { GAS unsigned long long* o8 = (GAS unsigned long long*)(dst16 + (size_t)m * D) + lane;
#pragma unroll
            for (int j = 0; j < 4; ++j) o8[64 * j] = (unsigned long long)pk2(v[j].x, v[j].y) | ((unsigned long long)pk2(v[j].z, v[j].w) << 32); }
    }
}
#ifndef MK_N_LAUNCHES
#define MK_N_LAUNCHES 1
#endif
constexpr int NPHASE = 13;
struct Args { const void* in[25]; float* out; unsigned char* ws; int ph_lo, ph_hi; };
__global__ void __launch_bounds__(NWAVES * 64, 2) fwd_kernel(Args args) {
    extern __shared__ __attribute__((aligned(16))) unsigned char lds[];
    Frame F;
    F.lds = (LAS unsigned char*)lds;
    F.MISC = (volatile LAS unsigned*)(F.lds + MISC_OFF);
    F.tid = threadIdx.x; F.lane = F.tid & 63; F.wave = __builtin_amdgcn_readfirstlane(F.tid >> 6);
    F.G = gridDim.x; { const int bx = blockIdx.x; F.vcu = (F.G % 8 == 0) ? (bx % 8) * (F.G / 8) + bx / 8 : bx; }
    F.ws = args.ws; F.out = args.out; F.ctl = (gu32*)(args.ws + WS_CTL);
    F.x_prompt = (const float*)args.in[0]; F.x_sample = (const float*)args.in[1]; F.cache_ckv = (const float*)args.in[2]; F.cache_kpe = (const float*)args.in[3]; F.state_conv = (const float*)args.in[4];
    F.page_table = (const int*)args.in[5]; F.meta = (const float*)args.in[6]; F.lne_g = (const float*)args.in[7]; F.lne_b = (const float*)args.in[8]; F.w_in = (const float*)args.in[9];
    F.qn_g = (const float*)args.in[10]; F.w_uq = (const float*)args.in[11]; F.kvn_g = (const float*)args.in[12]; F.w_uk = (const float*)args.in[13]; F.w_uv = (const float*)args.in[14];
    F.w_o_mla = (const float*)args.in[15]; F.conv_w = (const float*)args.in[16]; F.w_conv_out = (const float*)args.in[17]; F.w_o = (const float*)args.in[18]; F.ln1_g = (const float*)args.in[19];
    F.ln1_b = (const float*)args.in[20]; F.w_up = (const float*)args.in[21]; F.w_down = (const float*)args.in[22]; F.ln2_g = (const float*)args.in[23]; F.ln2_b = (const float*)args.in[24];
    for (int u = F.tid; u < (LDS_BYTES - LDSCTL_OFF) / 4; u += NWAVES * 64) ((LAS unsigned*)(F.lds + LDSCTL_OFF))[u] = 0u;
    __syncthreads();
    const int lo = args.ph_lo, hi = args.ph_hi;
    const bool one_phase = (hi - lo) == 1;
    XcdBarrier bar; bar.bar = (unsigned*)(F.ctl + CW_BAR); bar.x = 0; bar.st = nullptr;
    if (!one_phase) bar = xcd_barrier_post((unsigned*)(F.ctl + CW_BAR), F.MISC + 8);
#ifndef PH_MASK
#define PH_MASK 0xFFFFFFFFu
#endif
#define IN(k) ((((PH_MASK) >> (k)) & 1u) && lo <= (k) && (k) < hi)
#ifndef DUP_MASK
#define DUP_MASK 0u
#endif
#define REP(k) for (int rep_ = 0; rep_ < (int)(((DUP_MASK) >> (k)) & 1u) + 1; ++rep_)
#define SEAM(k) do { if (IN(k) && (IN((k) + 1) || ((k) == 6 && IN(8)))) xcd_barrier(bar); } while (0)
    using pg8::bf16_t;
    if (IN(0)) { REP(0) p0_prologue(F); SEAM(0); }
    if (IN(1)) {
        pg8::Gemm g{WSP(bf16_t, WS_XN), WSP(bf16_t, WS_WIN), M_ALL, NZ, D}; pg8::StaticOrder S; S.init(M_ALL, NZ, F.G, (int)blockIdx.x);
        epi::EpiZ E{WSP(float, WS_ZF), WSP(bf16_t, WS_GB), WSP(bf16_t, WS_U), WSP(bf16_t, WS_GCV), WSP(bf16_t, WS_GML), F.out + O_CONVP, F.out + O_CONVS};
        REP(1) pg8::gemm_phase<epi::EpiZ, pg8::StaticOrder, true, true>(F.lds + RING_OFF, g, S, E);
        SEAM(1);
    }
    if (IN(2)) { REP(2) p2_thin(F); SEAM(2); }
    if (IN(3)) REP(3) {
#ifndef P3S
#define P3S 7
#endif
        if (P3S & 1) { pg8::Gemm g{WSP(bf16_t, WS_CQN), WSP(bf16_t, WS_WUQ), M_ALL, 768, QLORA}; pg8::StaticOrder S; S.init(M_ALL, 768, F.G, (int)blockIdx.x);
          epi::EpiQ E{WSP(bf16_t, WS_Q), WSP(float, WS_TAB)};
          pg8::gemm_phase<epi::EpiQ, pg8::StaticOrder, true, true>(F.lds + RING_OFF, g, S, E); }
        if (P3S & 2) { pg8::Gemm g{WSP(bf16_t, WS_CKV), WSP(bf16_t, WS_WKV), M_ALL, 1024, KVL}; pg8::StaticOrder S; S.init(M_ALL, 1024, F.G, (int)blockIdx.x);
          epi::EpiBf16S<1024> E{WSP(bf16_t, WS_KV), 1.0f};
          pg8::gemm_phase<epi::EpiBf16S<1024>, pg8::StaticOrder, true, true>(F.lds + RING_OFF, g, S, E); }
        if (P3S & 4) { pg8::Gemm g{WSP(bf16_t, WS_CQN) + (size_t)ROW_S * QLORA, WSP(bf16_t, WS_WABS), M_S, 2048, QLORA}; pg8::StaticOrder S; S.init(M_S, 2048, F.G, (int)blockIdx.x);
          epi::EpiBf16S<2048> E{WSP(bf16_t, WS_QLAT), QSCALE};
          pg8::gemm_phase<epi::EpiBf16S<2048>, pg8::StaticOrder, true, true>(F.lds + RING_OFF, g, S, E); }
        SEAM(3);
    }
    if (IN(4)) { REP(13) pattn::prompt_phase(F.vcu, F.G, WSP(bf16, WS_Q), WSP(bf16, WS_KV), WSP(bf16, WS_KPE), WSP(bf16, WS_O), F.lds + RING_OFF);
        REP(4) for (int uu = F.vcu; uu < DBATCH * 2; uu += F.G) dattn::decode_unit(uu >> 1, uu & 1, F.cache_ckv, F.cache_kpe, F.page_table, WSP(bf16, WS_Q), WSP(bf16, WS_QLAT), WSP(bf16, WS_CKV), WSP(bf16, WS_KPE), WSP(float, WS_PART), F.lds + RING_OFF);
        SEAM(4); }
    if (IN(5)) { REP(5) decode_combine(F); SEAM(5); }
    if (IN(6)) {
        pg8::Gemm g{WSP(bf16_t, WS_CV), WSP(bf16_t, WS_WCO), M_ALL, D, CDIM}; pg8::StaticOrder S; S.init(M_ALL, D, F.G, (int)blockIdx.x);
        epi::EpiGateT E{WSP(bf16_t, WS_GCV), WSP(bf16_t, WS_T)};
        REP(6) pg8::gemm_phase<epi::EpiGateT, pg8::StaticOrder, true, true>(F.lds + RING_OFF, g, S, E);
    }
    if (IN(6)) {
        pg8::Gemm g{WSP(bf16_t, WS_O), WSP(bf16_t, WS_WOM), M_ALL, D, 512}; pg8::StaticOrder S; S.init(M_ALL, D, F.G, (int)blockIdx.x);
        epi::EpiMix E{WSP(bf16_t, WS_GML), WSP(bf16_t, WS_T), WSP(bf16_t, WS_MIXIN)};
        REP(7) pg8::gemm_phase<epi::EpiMix, pg8::StaticOrder, true, true>(F.lds + RING_OFF, g, S, E);
        SEAM(6);
    }
    if (IN(8)) {
        pg8::Gemm g{WSP(bf16_t, WS_MIXIN), WSP(bf16_t, WS_WO), M_ALL, D, D}; pg8::StaticOrder S; S.init(M_ALL, D, F.G, (int)blockIdx.x);
        epi::EpiRes E{WSP(bf16_t, WS_XN), WSP(float, WS_R1)};
        REP(8) pg8::gemm_phase<epi::EpiRes, pg8::StaticOrder, true, true>(F.lds + RING_OFF, g, S, E);
        SEAM(8);
    }
    if (IN(9)) { REP(9) ln_pass(F, WSP(float, WS_R1), F.ln1_g, F.ln1_b, nullptr, WSP(bf16, WS_H1N), ROW_M); SEAM(9); }
    if (IN(10)) {
        pg8::Gemm g{WSP(bf16_t, WS_H1N), WSP(bf16_t, WS_WUP), M_ALL, FF, D}; pg8::StaticOrder S; S.init(M_ALL, FF, F.G, (int)blockIdx.x);
        epi::EpiRelu2 E{WSP(bf16_t, WS_UP)};
        REP(10) pg8::gemm_phase<epi::EpiRelu2, pg8::StaticOrder, true, true>(F.lds + RING_OFF, g, S, E);
        SEAM(10);
    }
    if (IN(11)) {
        pg8::Gemm g{WSP(bf16_t, WS_UP), WSP(bf16_t, WS_WDN), M_ALL, D, FF}; pg8::StaticOrder S; S.init(M_ALL, D, F.G, (int)blockIdx.x);
        epi::EpiRes E{WSP(bf16_t, WS_H1N), WSP(float, WS_R2)};
        REP(11) pg8::gemm_phase<epi::EpiRes, pg8::StaticOrder, true, true>(F.lds + RING_OFF, g, S, E);
        SEAM(11);
    }
    if (IN(12)) { REP(12) ln_pass(F, WSP(float, WS_R2), F.ln2_g, F.ln2_b, F.out + O_YP, nullptr, ROW_M); }
#ifdef DBG_OFF
    {
        if (hi < NPHASE) xcd_barrier(bar);
        const bf16* B = WSP(bf16, DBG_OFF); const int gw = F.vcu * NWAVES + F.wave, NGW = F.G * NWAVES;
        for (int m = gw; m < ROW_M; m += NGW) for (int c = F.lane; c < D; c += 64) F.out[(size_t)m * D + c] = c < DBG_LD ? (DBG_C0 < 0 ? ((const float*)B)[(size_t)m * DBG_LD + c] : bf2f(B[(size_t)m * DBG_LD + c + (DBG_C0 < 0 ? 0 : DBG_C0)])) : 0.f;
    }
#endif
#undef IN
#undef SEAM
}

extern "C" void kernel_launch(void* const* d_in, const int* in_sizes, int n_in, void* d_out, int out_size, void* d_ws, size_t ws_size, hipStream_t stream) {
    static int grid = 0;
    if (grid == 0) {
        if (n_in != 25 || (size_t)out_size != O_END || ws_size < WS_END) { fprintf(stderr, "kernel_launch: unexpected shapes: n_in %d out %d ws %zu (need %zu)\n", n_in, out_size, ws_size, (size_t)WS_END); grid = -1; return; }
        int dev = 0, cus = 0, per_cu = 0;
        if (hipGetDevice(&dev) != hipSuccess || hipDeviceGetAttribute(&cus, hipDeviceAttributeMultiprocessorCount, dev) != hipSuccess) { grid = -1; return; }
        if (hipFuncSetAttribute((const void*)fwd_kernel, hipFuncAttributeMaxDynamicSharedMemorySize, LDS_BYTES) != hipSuccess) { fprintf(stderr, "kernel_launch: hipFuncSetAttribute failed\n"); grid = -1; return; }
        if (hipOccupancyMaxActiveBlocksPerMultiprocessor(&per_cu, (const void*)fwd_kernel, NWAVES * 64, LDS_BYTES) != hipSuccess || per_cu < 1)
            fprintf(stderr, "kernel_launch: note: occupancy query reports %d workgroups per CU\n", per_cu);
        (void)hipGetLastError();
        grid = cus;
    }
    if (grid < 0) return;
    if (hipMemsetAsync((char*)d_ws + WS_CTL, 0, CTL_ZERO_BYTES, stream) != hipSuccess) return;
    Args a{};
    for (int i = 0; i < 25; ++i) a.in[i] = d_in[i];
    a.out = (float*)d_out; a.ws = (unsigned char*)d_ws;
#if MK_N_LAUNCHES == 1
#ifndef PH_HI
#define PH_HI NPHASE
#endif
    a.ph_lo = 0; a.ph_hi = PH_HI;
    hipLaunchKernelGGL(fwd_kernel, dim3(grid), dim3(NWAVES * 64), LDS_BYTES, stream, a);
#else
    for (int p = 0; p < NPHASE; ++p) { a.ph_lo = p; a.ph_hi = p + 1; hipLaunchKernelGGL(fwd_kernel, dim3(grid), dim3(NWAVES * 64), LDS_BYTES, stream, a); }
#endif
}
```
